# Optimizing an MI355X kernel written in HIP

```python
import math
import jax
import jax.numpy as jnp
from jax import lax
import numpy as np

D_MODEL = 2048
BATCH = 2
SEQ = 4096
DEPTH = 1

HEAD_DIM = 128
MOBA_HEADS = D_MODEL // (2 * HEAD_DIM)
MOBA_WIDTH = MOBA_HEADS * HEAD_DIM
MOBA_BLOCK = 256
MOBA_TOPK = 3
MOBA_Q_CHUNK = 32
DIFF_HEAD_DIM = 128
DIFF_HEADS = D_MODEL // (4 * DIFF_HEAD_DIM)
DIFF_QK_WIDTH = DIFF_HEADS * 2 * DIFF_HEAD_DIM
DIFF_V_WIDTH = DIFF_HEADS * 2 * DIFF_HEAD_DIM
DIFF_Q_BLOCK = 128
N_ATTN_HEADS = MOBA_HEADS + DIFF_HEADS
REL_BUCKETS = 32
REL_MAX_DISTANCE = 128
MEM_LEN = 256
XATTN_HEADS = 4
XATTN_WIDTH = XATTN_HEADS * HEAD_DIM
N_EXPERTS = 32
TOP_K = 4
D_FF = D_MODEL
SWIGLU_LIMIT = 7.0
SWIGLU_ALPHA = 1.702
NORM_EPS = 1e-5
IN_SECTIONS = (MOBA_WIDTH, MOBA_WIDTH, MOBA_WIDTH, DIFF_QK_WIDTH, DIFF_QK_WIDTH, DIFF_V_WIDTH, D_MODEL, D_MODEL)
IN_COLS = 3 * MOBA_WIDTH + 2 * DIFF_QK_WIDTH + DIFF_V_WIDTH + 2 * D_MODEL

kernel_name = 'hybrid_moba_diffattn_xattn_moe_block'


def rms_norm(x, gain):
    xf = x.astype(jnp.float32)
    y = xf * lax.rsqrt(jnp.mean(xf * xf, axis=-1, keepdims=True) + NORM_EPS)
    return (y * gain.astype(jnp.float32)).astype(x.dtype)


def rel_bucket(dist):
    n = jnp.maximum(dist, 0)
    max_exact = REL_BUCKETS // 2
    nf = jnp.maximum(n, max_exact).astype(jnp.float32)
    large = max_exact + (jnp.log(nf / max_exact) / math.log(REL_MAX_DISTANCE / max_exact)
                         * (REL_BUCKETS - max_exact)).astype(jnp.int32)
    return jnp.where(n < max_exact, n, jnp.minimum(large, REL_BUCKETS - 1))


def moba_attention(q, k, v, table):
    b, nh, s, dh = q.shape
    nb = -(-s // MOBA_BLOCK)
    s_pad = nb * MOBA_BLOCK
    topk = min(MOBA_TOPK, nb)
    pad = ((0, 0), (0, 0), (0, s_pad - s), (0, 0))
    q, k, v = jnp.pad(q, pad), jnp.pad(k, pad), jnp.pad(v, pad)
    k_blocks = k.reshape(b * nh, nb, MOBA_BLOCK, dh)
    v_blocks = v.reshape(b * nh, nb, MOBA_BLOCK, dh)
    k_mean = jnp.mean(k_blocks.astype(jnp.float32), axis=2).reshape(b, nh, nb, dh)
    gather = jax.vmap(lambda blocks, idx: blocks[idx])
    head_ids = jnp.arange(nh)[None, :, None, None, None]
    offs = jnp.arange(MOBA_BLOCK)
    scale = dh ** -0.5

    def chunk(c):
        start = c * MOBA_Q_CHUNK
        blk = start // MOBA_BLOCK
        q_pos = start + jnp.arange(MOBA_Q_CHUNK)
        qc = lax.dynamic_slice_in_dim(q, start, MOBA_Q_CHUNK, axis=2)
        gate = jnp.einsum('bhqd,bhnd->bhqn', qc.astype(jnp.float32), k_mean)
        gate = jnp.where(jnp.arange(nb) < blk, gate, -jnp.inf)
        _, sel = lax.top_k(gate, topk)
        sel_flat = sel.reshape(b * nh, MOBA_Q_CHUNK, topk)
        k_sel = gather(k_blocks, sel_flat).reshape(b, nh, MOBA_Q_CHUNK, topk, MOBA_BLOCK, dh)
        v_sel = gather(v_blocks, sel_flat).reshape(b, nh, MOBA_Q_CHUNK, topk, MOBA_BLOCK, dh)
        k_own = lax.dynamic_slice_in_dim(k, blk * MOBA_BLOCK, MOBA_BLOCK, axis=2)
        v_own = lax.dynamic_slice_in_dim(v, blk * MOBA_BLOCK, MOBA_BLOCK, axis=2)
        kpos_sel = sel[..., None] * MOBA_BLOCK + offs
        bias_sel = table[rel_bucket(q_pos[:, None, None] - kpos_sel), head_ids]
        s_sel = jnp.einsum('bhqd,bhqjld->bhqjl', qc, k_sel).astype(jnp.float32) * scale + bias_sel
        s_sel = jnp.where((jnp.arange(topk) < blk)[:, None], s_sel, -jnp.inf)
        kpos_own = blk * MOBA_BLOCK + offs
        dist_own = q_pos[:, None] - kpos_own[None, :]
        bias_own = jnp.moveaxis(table[rel_bucket(dist_own)], -1, 0)
        s_own = jnp.einsum('bhqd,bhld->bhql', qc, k_own).astype(jnp.float32) * scale + bias_own
        s_own = jnp.where(dist_own >= 0, s_own, -jnp.inf)
        logits = jnp.concatenate([s_sel.reshape(b, nh, MOBA_Q_CHUNK, topk * MOBA_BLOCK), s_own], axis=-1)
        p = jax.nn.softmax(logits, axis=-1).astype(v.dtype)
        p_sel = p[..., :topk * MOBA_BLOCK].reshape(b, nh, MOBA_Q_CHUNK, topk, MOBA_BLOCK)
        p_own = p[..., topk * MOBA_BLOCK:]
        return (jnp.einsum('bhqjl,bhqjld->bhqd', p_sel, v_sel)
                + jnp.einsum('bhql,bhld->bhqd', p_own, v_own))

    out = lax.map(chunk, jnp.arange(s_pad // MOBA_Q_CHUNK))
    out = jnp.moveaxis(out, 0, 2).reshape(b, nh, s_pad, dh)
    return out[:, :, :s]


def diff_attention(q, k, v, table, lam):
    b, nh, _, s, dh = q.shape
    k_pos = jnp.arange(s)
    scale = dh ** -0.5

    def block(c):
        start = c * DIFF_Q_BLOCK
        q_pos = start + jnp.arange(DIFF_Q_BLOCK)
        qc = lax.dynamic_slice_in_dim(q, start, DIFF_Q_BLOCK, axis=3)
        dist = q_pos[:, None] - k_pos[None, :]
        bias = jnp.moveaxis(table[rel_bucket(dist)], -1, 0)[:, None]
        logits = jnp.einsum('bhiqd,bhikd->bhiqk', qc, k).astype(jnp.float32) * scale + bias
        logits = jnp.where(dist >= 0, logits, -jnp.inf)
        p = jax.nn.softmax(logits, axis=-1)
        attn = p[:, :, 0] - lam * p[:, :, 1]
        return jnp.einsum('bhqk,bhkd->bhqd', attn.astype(v.dtype), v)

    out = lax.map(block, jnp.arange(s // DIFF_Q_BLOCK))
    return jnp.moveaxis(out, 0, 2).reshape(b, nh, s, 2 * dh)


def cross_attention(h, mem_n, w_q, w_k, w_v, w_o):
    b, s, _ = h.shape
    m = mem_n.shape[1]
    q = (h @ w_q).reshape(b, s, XATTN_HEADS, HEAD_DIM)
    k = (mem_n @ w_k).reshape(b, m, XATTN_HEADS, HEAD_DIM)
    v = (mem_n @ w_v).reshape(b, m, XATTN_HEADS, HEAD_DIM)
    logits = jnp.einsum('bqhd,bmhd->bhqm', q, k).astype(jnp.float32) * (HEAD_DIM ** -0.5)
    p = jax.nn.softmax(logits, axis=-1).astype(v.dtype)
    o = jnp.einsum('bhqm,bmhd->bqhd', p, v).reshape(b, s, XATTN_WIDTH)
    return o @ w_o


def routed_ffn(h, w_router, b_router, w_gate_up, b_gate_up, w_down, b_down):
    b, s, d = h.shape
    t = h.reshape(b * s, d)
    logits = (t @ w_router).astype(jnp.float32) + b_router.astype(jnp.float32)
    top_val, top_idx = lax.top_k(logits, TOP_K)
    top_w = jax.nn.softmax(top_val, axis=-1)
    combine = jnp.sum(jax.nn.one_hot(top_idx, N_EXPERTS, dtype=jnp.float32) * top_w[..., None], axis=1)
    out = jnp.zeros((b * s, d), jnp.float32)
    for e in range(N_EXPERTS):
        gu = t @ w_gate_up[e] + b_gate_up[e]
        gate = jnp.minimum(gu[:, 0::2], SWIGLU_LIMIT)
        up = jnp.clip(gu[:, 1::2], -SWIGLU_LIMIT, SWIGLU_LIMIT)
        act = (up + 1.0) * gate * jax.nn.sigmoid(SWIGLU_ALPHA * gate)
        y = act @ w_down[e] + b_down[e]
        out = out + combine[:, e:e + 1] * y.astype(jnp.float32)
    return out.astype(h.dtype).reshape(b, s, d)


def split_heads(t, n_heads, head_dim):
    b, s, _ = t.shape
    return t.reshape(b, s, n_heads, head_dim).transpose(0, 2, 1, 3)


def split_pair_heads(t):
    b, s, _ = t.shape
    return t.reshape(b, s, DIFF_HEADS, 2, DIFF_HEAD_DIM).transpose(0, 2, 3, 1, 4)


def merge_heads(t):
    b, nh, s, dh = t.shape
    return t.transpose(0, 2, 1, 3).reshape(b, s, nh * dh)


def setup_inputs(seed: int = 0) -> dict:
    key = jax.random.key(seed)
    ks = jax.random.split(key, 32)
    f32 = jnp.float32

    def nrm(k, shape, scale):
        return jax.random.normal(k, shape, f32) * scale

    def gain(k, shape):
        return 1.0 + 0.01 * jax.random.normal(k, shape, f32)

    L = DEPTH
    return {
        'x': nrm(ks[0], (BATCH, SEQ, D_MODEL), 1.0),
        'mem': nrm(ks[1], (BATCH, MEM_LEN, D_MODEL), 1.0),
        'rel_bias_table': nrm(ks[2], (REL_BUCKETS, N_ATTN_HEADS), 0.5),
        'mix_norm': gain(ks[3], (L, D_MODEL)),
        'w_in': nrm(ks[4], (L, D_MODEL, IN_COLS), D_MODEL ** -0.5),
        'diff_lambda_q1': nrm(ks[5], (L, DIFF_HEAD_DIM), 0.1),
        'diff_lambda_k1': nrm(ks[6], (L, DIFF_HEAD_DIM), 0.1),
        'diff_lambda_q2': nrm(ks[7], (L, DIFF_HEAD_DIM), 0.1),
        'diff_lambda_k2': nrm(ks[8], (L, DIFF_HEAD_DIM), 0.1),
        'diff_subln': gain(ks[9], (L, 2 * DIFF_HEAD_DIM)),
        'w_branch_moba': nrm(ks[10], (L, MOBA_WIDTH, D_MODEL), MOBA_WIDTH ** -0.5),
        'w_branch_diff': nrm(ks[11], (L, DIFF_V_WIDTH, D_MODEL), DIFF_V_WIDTH ** -0.5),
        'w_mix_out': nrm(ks[12], (L, D_MODEL, D_MODEL), D_MODEL ** -0.5),
        'xattn_norm': gain(ks[13], (L, D_MODEL)),
        'mem_norm': gain(ks[14], (L, D_MODEL)),
        'w_xq': nrm(ks[15], (L, D_MODEL, XATTN_WIDTH), D_MODEL ** -0.5),
        'w_xk': nrm(ks[16], (L, D_MODEL, XATTN_WIDTH), D_MODEL ** -0.5),
        'w_xv': nrm(ks[17], (L, D_MODEL, XATTN_WIDTH), D_MODEL ** -0.5),
        'w_xo': nrm(ks[18], (L, XATTN_WIDTH, D_MODEL), XATTN_WIDTH ** -0.5),
        'ffn_norm': gain(ks[19], (L, D_MODEL)),
        'w_router': nrm(ks[20], (L, D_MODEL, N_EXPERTS), D_MODEL ** -0.5),
        'b_router': nrm(ks[21], (L, N_EXPERTS), 0.01),
        'w_gate_up': nrm(ks[22], (L, N_EXPERTS, D_MODEL, 2 * D_FF), D_MODEL ** -0.5),
        'b_gate_up': nrm(ks[23], (L, N_EXPERTS, 2 * D_FF), 0.01),
        'w_down': nrm(ks[24], (L, N_EXPERTS, D_FF, D_MODEL), D_FF ** -0.5),
        'b_down': nrm(ks[25], (L, N_EXPERTS, D_MODEL), 0.01),
        'final_norm': gain(ks[26], (D_MODEL,)),
    }


def reference(x, mem, rel_bias_table, mix_norm, w_in, diff_lambda_q1, diff_lambda_k1,
              diff_lambda_q2, diff_lambda_k2, diff_subln, w_branch_moba, w_branch_diff,
              w_mix_out, xattn_norm, mem_norm, w_xq, w_xk, w_xv, w_xo, ffn_norm,
              w_router, b_router, w_gate_up, b_gate_up, w_down, b_down, final_norm):
    splits = np.cumsum(IN_SECTIONS)[:-1].tolist()
    table_moba = rel_bias_table[:, :MOBA_HEADS]
    table_diff = rel_bias_table[:, MOBA_HEADS:]
    for l in range(DEPTH):
        h = rms_norm(x, mix_norm[l])
        qa, ka, va, qb, kb, vb, ga, gb = jnp.split(h @ w_in[l], splits, axis=-1)
        o_moba = moba_attention(split_heads(qa, MOBA_HEADS, HEAD_DIM), split_heads(ka, MOBA_HEADS, HEAD_DIM),
                                split_heads(va, MOBA_HEADS, HEAD_DIM), table_moba)
        o_moba = merge_heads(o_moba)
        lambda_init = 0.8 - 0.6 * math.exp(-0.3 * l)
        lam = (jnp.exp(jnp.sum(diff_lambda_q1[l].astype(jnp.float32) * diff_lambda_k1[l].astype(jnp.float32)))
               - jnp.exp(jnp.sum(diff_lambda_q2[l].astype(jnp.float32) * diff_lambda_k2[l].astype(jnp.float32)))
               + lambda_init)
        o_diff = diff_attention(split_pair_heads(qb), split_pair_heads(kb),
                                split_heads(vb, DIFF_HEADS, 2 * DIFF_HEAD_DIM), table_diff, lam)
        o_diff = merge_heads(rms_norm(o_diff, diff_subln[l]) * (1.0 - lambda_init))
        merged = (jax.nn.sigmoid(ga) * (o_moba @ w_branch_moba[l])
                  + jax.nn.sigmoid(gb) * (o_diff @ w_branch_diff[l]))
        x = x + merged @ w_mix_out[l]
        x = x + cross_attention(rms_norm(x, xattn_norm[l]), rms_norm(mem, mem_norm[l]),
                                w_xq[l], w_xk[l], w_xv[l], w_xo[l])
        x = x + routed_ffn(rms_norm(x, ffn_norm[l]), w_router[l], b_router[l], w_gate_up[l],
                           b_gate_up[l], w_down[l], b_down[l])
    return rms_norm(x, final_norm)
```

```cpp
#include <hip/hip_runtime.h>
#include <cstdio>
#include <cstdint>
#include <cmath>
namespace pg8 {
#define PG8_LAS __attribute__((address_space(3)))
typedef unsigned short bf16_t;
typedef short bf16x8 __attribute__((ext_vector_type(8)));
typedef float f32x4 __attribute__((ext_vector_type(4)));
typedef float f32x2 __attribute__((ext_vector_type(2)));
typedef unsigned u32x4 __attribute__((ext_vector_type(4)));
typedef unsigned u32x2 __attribute__((ext_vector_type(2)));
typedef long i64x2 __attribute__((ext_vector_type(2)));
typedef int i32x4 __attribute__((ext_vector_type(4)));
typedef int i32x8 __attribute__((ext_vector_type(8)));
constexpr int BM = 256, BK = 64, HALF = 128, HTB = HALF * BK * 2  , STAGE_BYTES = 8 * HTB, NXCD = 8, WGM = 8;

__host__ __device__ __forceinline__ int lds_byte(int r, int c) { const int st = (r >> 4) * 2 + (c >> 5), rr = r & 15, cc = c & 31, ob = rr * 64 + cc * 2; return st * 1024 + (ob ^ (((ob >> 9) & 1) << 5)); }
__host__ __device__ __forceinline__ void stage_rc(int b, int& R, int& C) { const int st = b / 1024, sb = b % 1024, swz = sb ^ (((sb >> 9) & 1) << 5); R = (st >> 1) * 16 + swz / 64; C = (st & 1) * 32 + (swz % 64) / 2; }
__host__ __device__ __forceinline__ int perm32(int rho) { const int n = rho >> 4, i = rho & 15; return 8 * (i >> 2) + 4 * n + (i & 3); }

struct Unit { int pm, pn, pb, e, lrow0, cnt, bjm; };
struct Gemm { const bf16_t* A; const bf16_t* Bt; int K; int lda, ldb; };

struct StaticOrder {
    int nM, nN, nwg, G, c, wgm;
    __device__ void init(int M, int N, int G_, int c_, int wgm_ = WGM) { nM = M / BM; nN = N / BM; nwg = nM * nN; G = G_; c = c_; wgm = wgm_; }
    __device__ bool next(int i, Unit& u) const {
        if (c < 0) return false;
        const long L = (long)i * G + c; if (L >= nwg) return false;
        int wgid = (int)L; { const int q = nwg / NXCD, r = nwg % NXCD, xcd = wgid % NXCD, off = wgid / NXCD; wgid = (xcd < r ? xcd * (q + 1) : r * (q + 1) + (xcd - r) * q) + off; }
        const int nig = wgm * nN, gid = wgid / nig, fm = gid * wgm, gsz = (nM - fm) < wgm ? (nM - fm) : wgm;
        u.pm = fm + ((wgid % nig) % gsz); u.pn = (wgid % nig) / gsz; u.pb = u.pn; u.e = 0; u.lrow0 = 0; u.cnt = 0; u.bjm = 3; return true;
    }
    __device__ __forceinline__ int arow(const Unit&, int) const { return 0; }
};

template <int KIND> struct PanelOrder {
    StaticOrder S;
    __device__ void init(int M, int G_, int c_, int wgm_) { S.init(M, (KIND ? 28 : 12) * BM, G_, c_, wgm_); }
    __device__ bool next(int i, Unit& u) const {
        if (!S.next(i, u)) return false;
        const int j = u.pn;
        if (KIND == 0) { u.pn = 12 + j; u.pb = u.pn; }
        else { u.pb = j; u.pn = j < 12 ? j : 12 + j; }
        return true;
    }
    __device__ __forceinline__ int arow(const Unit&, int) const { return 0; }
};
__device__ __forceinline__ void moe_decode(const PG8_LAS int* tab, int nN, int nwg, long L, int bjm, Unit& u) {
    int wgid = (int)L; { const int q = nwg / NXCD, r = nwg % NXCD, xcd = wgid % NXCD, off = wgid / NXCD; wgid = (xcd < r ? xcd * (q + 1) : r * (q + 1) + (xcd - r) * q) + off; }
    int e = 0;
    for (int j = 1; j < 32; ++j) if (tab[j] * nN <= wgid) e = j;
    const int t0 = tab[e], te = tab[e + 1] - t0, r = wgid - t0 * nN;
    const int pn = r / te, pl = r - pn * te;
    u.pm = t0 + pl; u.pn = pn; u.pb = e * nN + pn; u.e = e; u.lrow0 = pl * BM; u.cnt = tab[64 + e]; u.bjm = bjm;
}
__device__ __forceinline__ bool moe_split(int nwg, int G, int& R, int& rem) { R = nwg / G; rem = nwg - R * G; return rem > 0 && 2 * rem <= G && (G % NXCD) == 0; }
struct MoeOrder {
    const PG8_LAS int* tab; const int* tok; int nN, nwg, G, c, cap;
    __device__ void init(const PG8_LAS int* tab_, const int* tok_, int nN_, int G_, int c_, int cap_) { tab = tab_; tok = tok_; nN = nN_; G = G_; c = c_; cap = cap_; nwg = tab_[32] * nN_; }
    __device__ bool next(int i, Unit& u) const {
        int R, rem; const bool split = moe_split(nwg, G, R, rem);
        const long L = (long)i * G + c; if (L >= (split ? (long)R * G : (long)nwg)) return false;
        moe_decode(tab, nN, nwg, L, 3, u); return true;
    }
    __device__ __forceinline__ int arow(const Unit& u, int r) const { const int lr = u.lrow0 + r; return lr < u.cnt ? tok[(size_t)u.e * cap + lr] : 0; }
};
struct MoeTail {
    static constexpr bool ROWSKIP = true;
    const PG8_LAS int* tab; const int* tok; int nN, nwg, G, c, cap;
    __device__ void init(const PG8_LAS int* tab_, const int* tok_, int nN_, int G_, int c_, int cap_) { tab = tab_; tok = tok_; nN = nN_; G = G_; c = c_; cap = cap_; nwg = tab_[32] * nN_; }
    __device__ bool next(int i, Unit& u) const {
        int R, rem; if (i != 0 || !moe_split(nwg, G, R, rem)) return false;
        const int x = c % NXCD, sidx = c / NXCD, m = x + NXCD * (sidx >> 1);
        if (m >= rem) return false;
        moe_decode(tab, nN, nwg, (long)R * G + m, 1 << (sidx & 1), u); return true;
    }
    __device__ __forceinline__ int arow(const Unit& u, int r) const { const int lr = u.lrow0 + r; return lr < u.cnt ? tok[(size_t)u.e * cap + lr] : 0; }
};
template <class S, class = void> struct sched_rowskip { static constexpr bool value = false; };
template <class S> struct sched_rowskip<S, decltype((void)S::ROWSKIP)> { static constexpr bool value = true; };

__device__ __forceinline__ unsigned cvt_pk_bf16(float lo, float hi) { unsigned r; asm volatile("v_cvt_pk_bf16_f32 %0, %1, %2" : "=v"(r) : "v"(lo), "v"(hi)); return r; }
__device__ __forceinline__ unsigned pk4_fp8(float a, float b, float c, float d);
__device__ __forceinline__ float bf_lo(unsigned w) { return __builtin_bit_cast(float, w << 16); }
__device__ __forceinline__ float bf_hi(unsigned w) { return __builtin_bit_cast(float, w & 0xffff0000u); }
__device__ __forceinline__ float sigmoidf_(float x) { return __builtin_amdgcn_rcpf(1.0f + __builtin_amdgcn_exp2f(-1.4426950408889634f * x)); }

struct EpiBf16 {
    static constexpr bool PERM = true;
    bf16_t* O; int ldc; float scale;
    __device__ __forceinline__ void operator()(const f32x4 (&acc)[2][2][4][2], const Unit& u, int wr, int wc, int fr, int fq) const {
        const int row0 = u.pm * BM + wr * 64 + fr, col0 = u.pn * BM + wc * 32 + 8 * fq;
#pragma unroll
        for (int ai = 0; ai < 2; ++ai)
#pragma unroll
            for (int m = 0; m < 4; ++m) { bf16_t* rowp = O + (size_t)(row0 + ai * HALF + m * 16) * ldc + col0;
#pragma unroll
                for (int bj = 0; bj < 2; ++bj) { const f32x4 v0 = acc[ai][bj][m][0] * scale, v1 = acc[ai][bj][m][1] * scale;
                    u32x4 w; w.x = cvt_pk_bf16(v0[0], v0[1]); w.y = cvt_pk_bf16(v0[2], v0[3]); w.z = cvt_pk_bf16(v1[0], v1[1]); w.w = cvt_pk_bf16(v1[2], v1[3]);
                    *(u32x4*)(rowp + bj * HALF) = w; } }
    }
};
template <bool ADD> struct EpiGate {
    static constexpr bool PERM = true;
    const bf16_t* G; int ldg; const bf16_t* T; bf16_t* O; int ldc; float scale;
    __device__ __forceinline__ void operator()(const f32x4 (&acc)[2][2][4][2], const Unit& u, int wr, int wc, int fr, int fq) const {
        const int row0 = u.pm * BM + wr * 64 + fr, col0 = u.pn * BM + wc * 32 + 8 * fq;
#pragma unroll
        for (int ai = 0; ai < 2; ++ai) {
            u32x4 gv[4][2], tv[4][2];
#pragma unroll
            for (int m = 0; m < 4; ++m) { const size_t r = (size_t)(row0 + ai * HALF + m * 16);
#pragma unroll
                for (int bj = 0; bj < 2; ++bj) { gv[m][bj] = *(const u32x4*)(G + r * ldg + col0 + bj * HALF); if (ADD) tv[m][bj] = *(const u32x4*)(T + r * ldc + col0 + bj * HALF); } }
            asm volatile("" ::: "memory");
#pragma unroll
            for (int m = 0; m < 4; ++m) { const size_t r = (size_t)(row0 + ai * HALF + m * 16);
#pragma unroll
                for (int bj = 0; bj < 2; ++bj) { const f32x4 v0 = acc[ai][bj][m][0] * scale, v1 = acc[ai][bj][m][1] * scale;
                    const u32x4 g = gv[m][bj];
                    float o[8];
                    o[0] = v0[0] * sigmoidf_(bf_lo(g.x)); o[1] = v0[1] * sigmoidf_(bf_hi(g.x)); o[2] = v0[2] * sigmoidf_(bf_lo(g.y)); o[3] = v0[3] * sigmoidf_(bf_hi(g.y));
                    o[4] = v1[0] * sigmoidf_(bf_lo(g.z)); o[5] = v1[1] * sigmoidf_(bf_hi(g.z)); o[6] = v1[2] * sigmoidf_(bf_lo(g.w)); o[7] = v1[3] * sigmoidf_(bf_hi(g.w));
                    if (ADD) { const u32x4 t = tv[m][bj];
                        o[0] += bf_lo(t.x); o[1] += bf_hi(t.x); o[2] += bf_lo(t.y); o[3] += bf_hi(t.y); o[4] += bf_lo(t.z); o[5] += bf_hi(t.z); o[6] += bf_lo(t.w); o[7] += bf_hi(t.w); }
                    u32x4 w; w.x = cvt_pk_bf16(o[0], o[1]); w.y = cvt_pk_bf16(o[2], o[3]); w.z = cvt_pk_bf16(o[4], o[5]); w.w = cvt_pk_bf16(o[6], o[7]);
                    *(u32x4*)(O + r * ldc + col0 + bj * HALF) = w; } }
        }
    }
};
struct EpiResF32 {
    static constexpr bool PERM = false;
    const float* base; float* out; int ldc;
    __device__ __forceinline__ void operator()(const f32x4 (&acc)[2][2][4][2], const Unit& u, int wr, int wc, int fr, int fq) const {
        const int row0 = u.pm * BM + wr * 64 + fr, col0 = u.pn * BM + wc * 32 + 4 * fq;
#pragma unroll
        for (int ai = 0; ai < 2; ++ai) {
            f32x4 bs[4][2][2];
#pragma unroll
            for (int m = 0; m < 4; ++m) { const size_t off = (size_t)(row0 + ai * HALF + m * 16) * ldc + col0;
#pragma unroll
                for (int bj = 0; bj < 2; ++bj)
#pragma unroll
                    for (int n = 0; n < 2; ++n) bs[m][bj][n] = *(const f32x4*)(base + off + bj * HALF + n * 16); }
            asm volatile("" ::: "memory");
#pragma unroll
            for (int m = 0; m < 4; ++m) { const size_t off = (size_t)(row0 + ai * HALF + m * 16) * ldc + col0;
#pragma unroll
                for (int bj = 0; bj < 2; ++bj)
#pragma unroll
                    for (int n = 0; n < 2; ++n) *(f32x4*)(out + off + bj * HALF + n * 16) = bs[m][bj][n] + acc[ai][bj][m][n]; }
        }
    }
};
struct EpiResBf {
    static constexpr bool PERM = false;
    const bf16_t* base; float* out; int ldc;
    __device__ __forceinline__ void operator()(const f32x4 (&acc)[2][2][4][2], const Unit& u, int wr, int wc, int fr, int fq) const {
        const int row0 = u.pm * BM + wr * 64 + fr, col0 = u.pn * BM + wc * 32 + 4 * fq;
#pragma unroll
        for (int ai = 0; ai < 2; ++ai) {
            u32x2 bs[4][2][2];
#pragma unroll
            for (int m = 0; m < 4; ++m) { const size_t off = (size_t)(row0 + ai * HALF + m * 16) * ldc + col0;
#pragma unroll
                for (int bj = 0; bj < 2; ++bj)
#pragma unroll
                    for (int n = 0; n < 2; ++n) bs[m][bj][n] = *(const u32x2*)(base + off + bj * HALF + n * 16); }
            asm volatile("" ::: "memory");
#pragma unroll
            for (int m = 0; m < 4; ++m) { const size_t off = (size_t)(row0 + ai * HALF + m * 16) * ldc + col0;
#pragma unroll
                for (int bj = 0; bj < 2; ++bj)
#pragma unroll
                    for (int n = 0; n < 2; ++n) { const u32x2 w = bs[m][bj][n]; f32x4 r;
                        r[0] = __uint_as_float(w.x << 16); r[1] = __uint_as_float(w.x & 0xffff0000u); r[2] = __uint_as_float(w.y << 16); r[3] = __uint_as_float(w.y & 0xffff0000u);
                        *(f32x4*)(out + off + bj * HALF + n * 16) = r + acc[ai][bj][m][n]; } }
        }
    }
};
struct EpiResBfBf {
    static constexpr bool PERM = true;
    const bf16_t* base; bf16_t* out; int ldc;
    __device__ __forceinline__ void operator()(const f32x4 (&acc)[2][2][4][2], const Unit& u, int wr, int wc, int fr, int fq) const {
        const int row0 = u.pm * BM + wr * 64 + fr, col0 = u.pn * BM + wc * 32 + 8 * fq;
#pragma unroll
        for (int ai = 0; ai < 2; ++ai) {
            u32x4 tv[4][2];
#pragma unroll
            for (int m = 0; m < 4; ++m) { const size_t r = (size_t)(row0 + ai * HALF + m * 16);
#pragma unroll
                for (int bj = 0; bj < 2; ++bj) tv[m][bj] = *(const u32x4*)(base + r * ldc + col0 + bj * HALF); }
            asm volatile("" ::: "memory");
#pragma unroll
            for (int m = 0; m < 4; ++m) { const size_t r = (size_t)(row0 + ai * HALF + m * 16);
#pragma unroll
                for (int bj = 0; bj < 2; ++bj) { const f32x4 v0 = acc[ai][bj][m][0], v1 = acc[ai][bj][m][1]; const u32x4 t = tv[m][bj];
                    u32x4 w; w.x = cvt_pk_bf16(v0[0] + bf_lo(t.x), v0[1] + bf_hi(t.x)); w.y = cvt_pk_bf16(v0[2] + bf_lo(t.y), v0[3] + bf_hi(t.y));
                    w.z = cvt_pk_bf16(v1[0] + bf_lo(t.z), v1[1] + bf_hi(t.z)); w.w = cvt_pk_bf16(v1[2] + bf_lo(t.w), v1[3] + bf_hi(t.w));
                    *(u32x4*)(out + r * ldc + col0 + bj * HALF) = w; } }
        }
    }
};
struct EpiQKV8 {
    static constexpr bool PERM = true;
    bf16_t* O; int ldc;
    __device__ __forceinline__ void operator()(const f32x4 (&acc)[2][2][4][2], const Unit& u, int wr, int wc, int fr, int fq) const {
        const int row0 = u.pm * BM + wr * 64 + fr, col0 = u.pn * BM + wc * 32 + 8 * fq;
        const float sc = 1.0f / 64.0f;
#pragma unroll
        for (int ai = 0; ai < 2; ++ai)
#pragma unroll
            for (int m = 0; m < 4; ++m) { bf16_t* rowp = O + (size_t)(row0 + ai * HALF + m * 16) * ldc + col0;
#pragma unroll
                for (int bj = 0; bj < 2; ++bj) { const f32x4 v0 = acc[ai][bj][m][0] * sc, v1 = acc[ai][bj][m][1] * sc;
                    u32x4 w; w.x = cvt_pk_bf16(v0[0], v0[1]); w.y = cvt_pk_bf16(v0[2], v0[3]); w.z = cvt_pk_bf16(v1[0], v1[1]); w.w = cvt_pk_bf16(v1[2], v1[3]);
                    *(u32x4*)(rowp + bj * HALF) = w; } }
    }
};
struct EpiQKV {
    static constexpr bool PERM = true;
    bf16_t* O; int ldc; float* kmean; float scale;
    __device__ __forceinline__ void operator()(const f32x4 (&acc)[2][2][4][2], const Unit& u, int wr, int wc, int fr, int fq) const {
        const int row0 = u.pm * BM + wr * 64 + fr, col0 = u.pn * BM + wc * 32 + 8 * fq;
#pragma unroll
        for (int ai = 0; ai < 2; ++ai)
#pragma unroll
            for (int m = 0; m < 4; ++m) { bf16_t* rowp = O + (size_t)(row0 + ai * HALF + m * 16) * ldc + col0;
#pragma unroll
                for (int bj = 0; bj < 2; ++bj) { const f32x4 v0 = acc[ai][bj][m][0] * scale, v1 = acc[ai][bj][m][1] * scale;
                    u32x4 w; w.x = cvt_pk_bf16(v0[0], v0[1]); w.y = cvt_pk_bf16(v0[2], v0[3]); w.z = cvt_pk_bf16(v1[0], v1[1]); w.w = cvt_pk_bf16(v1[2], v1[3]);
                    *(u32x4*)(rowp + bj * HALF) = w; } }
        if (u.pn >= 4 && u.pn < 8) {
            float cs[2][8];
#pragma unroll
            for (int bj = 0; bj < 2; ++bj)
#pragma unroll
                for (int j = 0; j < 8; ++j) { float s = 0.f;
#pragma unroll
                    for (int ai = 0; ai < 2; ++ai)
#pragma unroll
                        for (int m = 0; m < 4; ++m) s += acc[ai][bj][m][j >> 2][j & 3];
                    s += __shfl_xor(s, 1); s += __shfl_xor(s, 2); s += __shfl_xor(s, 4); s += __shfl_xor(s, 8);
                    cs[bj][j] = s; }
            if (fr == 0) { const int b = u.pm >> 4, nb = u.pm & 15;
#pragma unroll
                for (int bj = 0; bj < 2; ++bj)
#pragma unroll
                    for (int j = 0; j < 8; ++j) { const int col = 128 * bj + 32 * wc + 8 * fq + j, h = 2 * (u.pn - 4) + (col >> 7), d = col & 127;
                        atomicAdd(kmean + (size_t)((b * 8 + h) * 16 + nb) * 128 + d, cs[bj][j] * (scale * (1.0f / 256.0f))); } }
        }
    }
};
struct EpiResF32X {
    static constexpr bool PERM = false;
    const float* base; float* out; int ldc; bf16_t* xb; float* ss; unsigned char* x8; const float* gain; int ld8;
    __device__ __forceinline__ void operator()(const f32x4 (&acc)[2][2][4][2], const Unit& u, int wr, int wc, int fr, int fq) const {
        const int row0 = u.pm * BM + wr * 64 + fr, col0 = u.pn * BM + wc * 32 + 4 * fq;
        f32x4 gv[2][2];
#pragma unroll
        for (int bj = 0; bj < 2; ++bj)
#pragma unroll
            for (int n = 0; n < 2; ++n) gv[bj][n] = *(const f32x4*)(gain + col0 + bj * HALF + n * 16);
#pragma unroll
        for (int ai = 0; ai < 2; ++ai) {
            f32x4 bs[4][2][2];
#pragma unroll
            for (int m = 0; m < 4; ++m) { const size_t off = (size_t)(row0 + ai * HALF + m * 16) * ldc + col0;
#pragma unroll
                for (int bj = 0; bj < 2; ++bj)
#pragma unroll
                    for (int n = 0; n < 2; ++n) bs[m][bj][n] = *(const f32x4*)(base + off + bj * HALF + n * 16); }
            asm volatile("" ::: "memory");
#pragma unroll
            for (int m = 0; m < 4; ++m) { const int r = row0 + ai * HALF + m * 16; const size_t off = (size_t)r * ldc + col0; float s2 = 0.f;
#pragma unroll
                for (int bj = 0; bj < 2; ++bj)
#pragma unroll
                    for (int n = 0; n < 2; ++n) { const f32x4 x = bs[m][bj][n] + acc[ai][bj][m][n];
                        if (out) *(f32x4*)(out + off + bj * HALF + n * 16) = x; s2 += (x[0] * x[0] + x[1] * x[1]) + (x[2] * x[2] + x[3] * x[3]);
                        u32x2 w; w.x = cvt_pk_bf16(x[0], x[1]); w.y = cvt_pk_bf16(x[2], x[3]); *(u32x2*)(xb + off + bj * HALF + n * 16) = w;
                        const f32x4 g = gv[bj][n]; *(unsigned*)(x8 + (size_t)r * ld8 + col0 + bj * HALF + n * 16) = pk4_fp8(x[0] * g[0], x[1] * g[1], x[2] * g[2], x[3] * g[3]); }
                s2 += __shfl_xor(s2, 16); s2 += __shfl_xor(s2, 32);
                if (fq == 0) ss[(size_t)r * 32 + u.pn * 4 + wc] = s2; }
        }
    }
};
struct EpiXQ {
    static constexpr bool PERM = true;
    bf16_t* O; int ldc; const float* ss; float eps; float scale;
    __device__ __forceinline__ void operator()(const f32x4 (&acc)[2][2][4][2], const Unit& u, int wr, int wc, int fr, int fq) const {
        const int row0 = u.pm * BM + wr * 64 + fr, col0 = u.pn * BM + wc * 32 + 8 * fq;
#pragma unroll
        for (int ai = 0; ai < 2; ++ai)
#pragma unroll
            for (int m = 0; m < 4; ++m) { const int r = row0 + ai * HALF + m * 16; float s = 0.f;
#pragma unroll
                for (int j = 0; j < 8; ++j) { const f32x4 t = *(const f32x4*)(ss + (size_t)r * 32 + 4 * j); s += (t[0] + t[1]) + (t[2] + t[3]); }
                const float rstd = scale / sqrtf(s * (1.0f / 2048.0f) + eps);
                bf16_t* rowp = O + (size_t)r * ldc + col0;
#pragma unroll
                for (int bj = 0; bj < 2; ++bj) { const f32x4 v0 = acc[ai][bj][m][0] * rstd, v1 = acc[ai][bj][m][1] * rstd;
                    u32x4 w; w.x = cvt_pk_bf16(v0[0], v0[1]); w.y = cvt_pk_bf16(v0[2], v0[3]); w.z = cvt_pk_bf16(v1[0], v1[1]); w.w = cvt_pk_bf16(v1[2], v1[3]);
                    *(u32x4*)(rowp + bj * HALF) = w; } }
    }
};
__device__ __forceinline__ float swiglu_(float g, float up) { g = fminf(g, 7.0f); up = fminf(fmaxf(up, -7.0f), 7.0f); return (up + 1.0f) * g * sigmoidf_(1.702f * g); }
__device__ __forceinline__ unsigned pk4_fp8(float a, float b, float c, float d) { int w = 0; w = __builtin_amdgcn_cvt_pk_fp8_f32(a, b, w, false); w = __builtin_amdgcn_cvt_pk_fp8_f32(c, d, w, true); return (unsigned)w; }
constexpr float W8_SCALE = 64.0f, W8_INV = 1.0f / 64.0f;
struct EpiGU {
    static constexpr bool PERM = true;
    const float* bias; unsigned char* ACT; int lda;
    __device__ __forceinline__ void operator()(const f32x4 (&acc)[2][2][4][2], const Unit& u, int wr, int wc, int fr, int fq) const {
        const int row0 = u.pm * BM + wr * 64 + fr, col0 = u.pn * BM + wc * 32 + 8 * fq;
        f32x4 bv[2][2];
#pragma unroll
        for (int bj = 0; bj < 2; ++bj)
#pragma unroll
            for (int n = 0; n < 2; ++n) bv[bj][n] = *(const f32x4*)(bias + (size_t)u.e * 4096 + col0 + bj * HALF + 4 * n);
#pragma unroll
        for (int ai = 0; ai < 2; ++ai)
#pragma unroll
            for (int m = 0; m < 4; ++m) { unsigned char* rowp = ACT + (size_t)(row0 + ai * HALF + m * 16) * lda + (col0 >> 1);
#pragma unroll
                for (int bj = 0; bj < 2; ++bj) { if (!((u.bjm >> bj) & 1)) continue; const f32x4 v0 = acc[ai][bj][m][0] * W8_INV + bv[bj][0], v1 = acc[ai][bj][m][1] * W8_INV + bv[bj][1];
                    *(unsigned*)(rowp + bj * (HALF / 2)) = pk4_fp8(swiglu_(v0[0], v0[1]), swiglu_(v0[2], v0[3]), swiglu_(v1[0], v1[1]), swiglu_(v1[2], v1[3])); } }
    }
};
struct EpiDown {
    static constexpr bool PERM = true;
    const float* bias; const float* cw; int cap; bf16_t* Y;
    __device__ __forceinline__ void operator()(const f32x4 (&acc)[2][2][4][2], const Unit& u, int wr, int wc, int fr, int fq) const {
        const int row0 = u.pm * BM + wr * 64 + fr, col0 = u.pn * BM + wc * 32 + 8 * fq, lrow0 = u.lrow0 + wr * 64 + fr;
        f32x4 bv[2][2];
#pragma unroll
        for (int bj = 0; bj < 2; ++bj)
#pragma unroll
            for (int n = 0; n < 2; ++n) bv[bj][n] = *(const f32x4*)(bias + (size_t)u.e * 2048 + col0 + bj * HALF + 4 * n);
#pragma unroll
        for (int ai = 0; ai < 2; ++ai)
#pragma unroll
            for (int m = 0; m < 4; ++m) { const int lr = lrow0 + ai * HALF + m * 16; const float s = lr < u.cnt ? cw[(size_t)u.e * cap + lr] : 0.f;
                bf16_t* rowp = Y + (size_t)(row0 + ai * HALF + m * 16) * 2048 + col0;
#pragma unroll
                for (int bj = 0; bj < 2; ++bj) { if (!((u.bjm >> bj) & 1)) continue; const f32x4 v0 = (acc[ai][bj][m][0] * W8_INV + bv[bj][0]) * s, v1 = (acc[ai][bj][m][1] * W8_INV + bv[bj][1]) * s;
                    u32x4 w; w.x = cvt_pk_bf16(v0[0], v0[1]); w.y = cvt_pk_bf16(v0[2], v0[3]); w.z = cvt_pk_bf16(v1[0], v1[1]); w.w = cvt_pk_bf16(v1[2], v1[3]);
                    *(u32x4*)(rowp + bj * HALF) = w; } }
    }
};

template <class Epi, class Sched, bool ALIGN_EPI, bool GATHER, bool FP8 = false>
__device__ __forceinline__ void gemm_phase(PG8_LAS unsigned char* lds, const Gemm g, const Sched& S, const Epi& E, const int tid) {
    const int wid = __builtin_amdgcn_readfirstlane(tid >> 6), lane = tid & 63, wr = wid >> 2, wc = wid & 3, fr = lane & 15, fq = lane >> 4;
    const int K = g.K, RB = FP8 ? K : 2 * K, nt = RB / (2 * BK);
    const int RBA = g.lda ? g.lda : RB, RBB = g.ldb ? g.ldb : RB;
    int sR[2], sC[2];
    unsigned voffA[2], voffB[2];
#pragma unroll
    for (int i = 0; i < 2; ++i) { int R, C; stage_rc(tid * 16 + i * 8192, R, C); const int Rb = Epi::PERM ? ((R & ~31) + perm32(R & 31)) : R;
        sR[i] = R; sC[i] = C; voffA[i] = (unsigned)(R * RBA + C * 2); voffB[i] = (unsigned)(Rb * RBB + C * 2); }
    const size_t kstep = (size_t)(BK * 2);
    const size_t hstepB = (size_t)HALF * RBB;
    const size_t hstepA = GATHER ? 0 : (size_t)HALF * RBA;
    const size_t tstepA = (size_t)BM * RBA, tstep = 2 * hstepB;
    const unsigned ldsw = (unsigned)wid * 1024u;
    const int aoff = lds_byte(wr * 64 + fr, fq * 8), boff = lds_byte(wc * 32 + fr, fq * 8);
    unsigned cv[2][2], nv[2][2];
#define PG8_SA(b, h) (((b) * 2 + (h)) * HTB)
#define PG8_SB(b, h) ((4 + (b) * 2 + (h)) * HTB)
#define PG8_STAGE(bufoff, gbase, voff) do { _Pragma("unroll") for (int _i = 0; _i < 2; ++_i) \
        __builtin_amdgcn_global_load_lds((const unsigned*)((const char*)(gbase) + (voff)[_i]), (PG8_LAS unsigned*)(lds + (bufoff) + ldsw + _i * 8192), 16, 0, 0); } while (0)
#define PG8_STAGE_A(bufoff, gbase, h, nx) do { if constexpr (GATHER) { _Pragma("unroll") for (int _i = 0; _i < 2; ++_i) { const unsigned vo_ = (nx) ? nv[h][_i] : cv[h][_i]; \
        __builtin_amdgcn_global_load_lds((const unsigned*)((const char*)(gbase) + vo_), (PG8_LAS unsigned*)(lds + (bufoff) + ldsw + _i * 8192), 16, 0, 0); } } \
        else { PG8_STAGE(bufoff, (const char*)(gbase) + (h) * hstepA, voffA); } } while (0)
#define PG8_LD8(addr) __builtin_shufflevector(*(const PG8_LAS i32x4*)(addr), *(const PG8_LAS i32x4*)((addr) + 1024), 0, 1, 2, 3, 4, 5, 6, 7)
#define PG8_LDA(dst, b, h) do { if constexpr (FP8) { _Pragma("unroll") for (int m = 0; m < 4; ++m) dst##8[m] = PG8_LD8(lds + PG8_SA(b, h) + aoff + m * 2048); } \
        else { _Pragma("unroll") for (int m = 0; m < 4; ++m) _Pragma("unroll") for (int k = 0; k < 2; ++k) dst[m][k] = *(const PG8_LAS bf16x8*)(lds + PG8_SA(b, h) + aoff + m * 2048 + k * 1024); } } while (0)
#define PG8_LDB(dst, b, h) do { if constexpr (FP8) { _Pragma("unroll") for (int n = 0; n < 2; ++n) dst##8[n] = PG8_LD8(lds + PG8_SB(b, h) + boff + n * 2048); } \
        else { _Pragma("unroll") for (int n = 0; n < 2; ++n) _Pragma("unroll") for (int k = 0; k < 2; ++k) dst[n][k] = *(const PG8_LAS bf16x8*)(lds + PG8_SB(b, h) + boff + n * 2048 + k * 1024); } } while (0)
#define PG8_MMA(ai, bj, At, Bt) do { __builtin_amdgcn_s_setprio(1); \
        if constexpr (FP8) { _Pragma("unroll") for (int m = 0; m < 4; ++m) _Pragma("unroll") for (int n = 0; n < 2; ++n) \
            asm volatile("v_mfma_scale_f32_16x16x128_f8f6f4 %0, %1, %2, %0, %3, %3 op_sel_hi:[0,0,0]" : "+v"(acc[ai][bj][m][n]) : "v"(Bt##8[n]), "v"(At##8[m]), "v"(mxs)); } \
        else { _Pragma("unroll") for (int m = 0; m < 4; ++m) _Pragma("unroll") for (int n = 0; n < 2; ++n) _Pragma("unroll") for (int k = 0; k < 2; ++k) \
            acc[ai][bj][m][n] = __builtin_amdgcn_mfma_f32_16x16x32_bf16(Bt[n][k], At[m][k], acc[ai][bj][m][n], 0, 0, 0); } __builtin_amdgcn_s_setprio(0); } while (0)
#define PG8_WAIT_V(n) asm volatile("s_waitcnt vmcnt(" #n ")" ::: "memory")
#define PG8_WAIT_L(n) asm volatile("s_waitcnt lgkmcnt(" #n ")" ::: "memory")
#define PG8_BAR __builtin_amdgcn_s_barrier()
#define PG8_SCHED __builtin_amdgcn_sched_barrier(0)
#define PG8_GOFF(dst, u) do { if constexpr (GATHER) { _Pragma("unroll") for (int _h = 0; _h < 2; ++_h) _Pragma("unroll") for (int _i = 0; _i < 2; ++_i) \
        dst[_h][_i] = (unsigned)(S.arow(u, _h * HALF + sR[_i]) * RBA + sC[_i] * 2); } } while (0)
    Unit cur, nxt; int ui = 0;
    if (!S.next(0, cur)) return;
    f32x4 acc[2][2][4][2];
#pragma unroll
    for (int a = 0; a < 2; ++a)
#pragma unroll
        for (int b = 0; b < 2; ++b)
#pragma unroll
            for (int m = 0; m < 4; ++m)
#pragma unroll
                for (int n = 0; n < 2; ++n) acc[a][b][m][n] = (f32x4){0.f, 0.f, 0.f, 0.f};
    const int mxs = 0x7F7F7F7F;
    bf16x8 At[4][2], B0[2][2], B1[2][2]; i32x8 At8[4], B08[2], B18[2];
    const char* cA = GATHER ? (const char*)g.A : (const char*)g.A + (size_t)cur.pm * tstepA; const char* cB = (const char*)g.Bt + (size_t)cur.pb * tstep;
    PG8_GOFF(cv, cur);
#pragma unroll
    for (int _h = 0; _h < 2; ++_h)
#pragma unroll
        for (int _i = 0; _i < 2; ++_i) nv[_h][_i] = cv[_h][_i];
    PG8_STAGE(PG8_SB(0, 0), cB, voffB); PG8_STAGE(PG8_SB(0, 1), cB + hstepB, voffB); PG8_STAGE_A(PG8_SA(0, 0), cA, 0, false); PG8_STAGE_A(PG8_SA(0, 1), cA, 1, false);
    if (wr == 1) PG8_BAR;
    PG8_WAIT_V(2); PG8_BAR;
    PG8_STAGE(PG8_SB(1, 0), cB + kstep, voffB); PG8_STAGE_A(PG8_SA(1, 0), cA + kstep, 0, false); PG8_STAGE(PG8_SB(1, 1), cB + hstepB + kstep, voffB);
    PG8_WAIT_V(6); PG8_BAR;
    for (;;) {
        const bool has_next = S.next(ui + 1, nxt);
        if (has_next) PG8_GOFF(nv, nxt);
        const char* nA = GATHER ? (const char*)g.A : (has_next ? (const char*)g.A + (size_t)nxt.pm * tstepA : cA); const char* nB = has_next ? (const char*)g.Bt + (size_t)nxt.pb * tstep : cB;
        bool act0 = true, act1 = true;
        bool b0on = true, b1on = true;
        if constexpr (sched_rowskip<Sched>::value) { const int vr = cur.cnt - cur.lrow0; act0 = wr * 64 < vr; act1 = HALF + wr * 64 < vr; b0on = (cur.bjm & 1) != 0; b1on = (cur.bjm & 2) != 0; }
        for (int t = 0; t < nt; t += 2) {
            const bool last = (t == nt - 2);
            const char* a1 = cA + (size_t)(t + 1) * kstep;
            const char* a2 = last ? nA : cA + (size_t)(t + 2) * kstep; const char* b2 = last ? nB : cB + (size_t)(t + 2) * kstep;
            const char* a3 = a2 + kstep; const char* b3 = b2 + kstep;
            const bool nx = last && has_next;
            if (act0) { if (b0on) PG8_LDB(B0, 0, 0); if (b1on) PG8_LDB(B1, 0, 1); PG8_SCHED; PG8_LDA(At, 0, 0); } PG8_STAGE_A(PG8_SA(1, 1), a1, 1, false);
            PG8_WAIT_V(8); PG8_WAIT_L(0); PG8_BAR; if (act0) { if (b0on) PG8_MMA(0, 0, At, B0); if (b1on) PG8_MMA(0, 1, At, B1); } PG8_BAR; PG8_SCHED;
            if (act1) { PG8_LDA(At, 0, 1); } PG8_STAGE(PG8_SB(0, 0), b2, voffB); PG8_STAGE(PG8_SB(0, 1), b2 + hstepB, voffB); PG8_STAGE_A(PG8_SA(0, 0), a2, 0, nx);
            PG8_WAIT_V(8); PG8_WAIT_L(0); PG8_BAR; if (act1) { if (b0on) PG8_MMA(1, 0, At, B0); if (b1on) PG8_MMA(1, 1, At, B1); } PG8_BAR; PG8_SCHED;
            if (act0) { if (b0on) PG8_LDB(B0, 1, 0); if (b1on) PG8_LDB(B1, 1, 1); PG8_SCHED; PG8_LDA(At, 1, 0); } PG8_STAGE_A(PG8_SA(0, 1), a2, 1, nx);
            PG8_WAIT_V(8); PG8_WAIT_L(0); PG8_BAR; if (act0) { if (b0on) PG8_MMA(0, 0, At, B0); if (b1on) PG8_MMA(0, 1, At, B1); } PG8_BAR; PG8_SCHED;
            if (act1) { PG8_LDA(At, 1, 1); } PG8_STAGE(PG8_SB(1, 0), b3, voffB); PG8_STAGE(PG8_SB(1, 1), b3 + hstepB, voffB); PG8_STAGE_A(PG8_SA(1, 0), a3, 0, nx);
            PG8_WAIT_V(8); PG8_WAIT_L(0); PG8_BAR; if (act1) { if (b0on) PG8_MMA(1, 0, At, B0); if (b1on) PG8_MMA(1, 1, At, B1); } PG8_BAR; PG8_SCHED;
        }
        if constexpr (ALIGN_EPI) { if (wr == 0) PG8_BAR; }
        if constexpr (FP8) {
            asm volatile("s_nop 15\n\ts_nop 15" : "+v"(acc[0][0][0][0]), "+v"(acc[0][0][0][1]), "+v"(acc[0][0][1][0]), "+v"(acc[0][0][1][1]), "+v"(acc[0][0][2][0]), "+v"(acc[0][0][2][1]), "+v"(acc[0][0][3][0]), "+v"(acc[0][0][3][1]),
                                                   "+v"(acc[0][1][0][0]), "+v"(acc[0][1][0][1]), "+v"(acc[0][1][1][0]), "+v"(acc[0][1][1][1]), "+v"(acc[0][1][2][0]), "+v"(acc[0][1][2][1]), "+v"(acc[0][1][3][0]), "+v"(acc[0][1][3][1]));
            asm volatile("" : "+v"(acc[1][0][0][0]), "+v"(acc[1][0][0][1]), "+v"(acc[1][0][1][0]), "+v"(acc[1][0][1][1]), "+v"(acc[1][0][2][0]), "+v"(acc[1][0][2][1]), "+v"(acc[1][0][3][0]), "+v"(acc[1][0][3][1]),
                              "+v"(acc[1][1][0][0]), "+v"(acc[1][1][0][1]), "+v"(acc[1][1][1][0]), "+v"(acc[1][1][1][1]), "+v"(acc[1][1][2][0]), "+v"(acc[1][1][2][1]), "+v"(acc[1][1][3][0]), "+v"(acc[1][1][3][1])); }
        E(acc, cur, wr, wc, fr, fq);
        if (!has_next) break;
#pragma unroll
        for (int a = 0; a < 2; ++a)
#pragma unroll
            for (int b = 0; b < 2; ++b)
#pragma unroll
                for (int m = 0; m < 4; ++m)
#pragma unroll
                    for (int n = 0; n < 2; ++n) acc[a][b][m][n] = (f32x4){0.f, 0.f, 0.f, 0.f};
        cur = nxt; cA = nA; cB = nB; ++ui;
#pragma unroll
        for (int _h = 0; _h < 2; ++_h)
#pragma unroll
            for (int _i = 0; _i < 2; ++_i) cv[_h][_i] = nv[_h][_i];
        if constexpr (ALIGN_EPI) { if (wr == 1) PG8_BAR; }
    }
    PG8_WAIT_V(0);
    if constexpr (!ALIGN_EPI) { if (wr == 0) PG8_BAR; }
    PG8_BAR;
#undef PG8_SA
#undef PG8_SB
#undef PG8_STAGE
#undef PG8_STAGE_A
#undef PG8_LDA
#undef PG8_LD8
#undef PG8_LDB
#undef PG8_MMA
#undef PG8_WAIT_V
#undef PG8_WAIT_L
#undef PG8_BAR
#undef PG8_SCHED
#undef PG8_GOFF
}
}
namespace att {
typedef unsigned short bf16;
typedef short bf16x8 __attribute__((ext_vector_type(8)));
typedef short s16x4 __attribute__((ext_vector_type(4)));
typedef float f32x16 __attribute__((ext_vector_type(16)));
typedef float f32x4 __attribute__((ext_vector_type(4)));
typedef unsigned u32x4 __attribute__((ext_vector_type(4)));
constexpr int D = 128;
constexpr float SCALE = 0.08838834764831845f;
constexpr float THR = 8.f;
constexpr int NW = 8, QBLK = 32, KVBLK = 64, QB = NW * QBLK;
constexpr int SHM_V = KVBLK * D * 2, SHM_K = KVBLK * D * 2;
constexpr int LDS_WS_OFF = 2 * SHM_V + 2 * SHM_K, LDS_LUT_OFF = LDS_WS_OFF + NW * 64 * 4, LDS_BYTES = LDS_LUT_OFF + 128 * 4;

#define KSWZ(row, colB) ((row) * 256 + ((colB) ^ (((row) & 7) << 4)))
#define SBAR() __builtin_amdgcn_sched_barrier(0)
__device__ __forceinline__ int v_st(int k, int c) { const int kk = (k & ~0xC) | ((k & 4) << 1) | ((k & 8) >> 1); return ((kk >> 3) * 4 + (c >> 5)) * 512 + ((kk & 7) * 32 + (c & 31)) * 2; }
__device__ __forceinline__ int v_rd_base(int lane) { return ((lane & 3) << 3) | (((lane >> 2) & 3) << 6) | (((lane >> 4) & 1) << 5) | (((lane >> 5) & 1) << 8); }
constexpr int v_rd_off(int d0, int ks, int half) { return d0 * 512 + ks * 4096 + half * 2048; }
__device__ __forceinline__ int crow(int r, int hi) { return (r & 3) + 8 * (r >> 2) + 4 * hi; }
__device__ __forceinline__ unsigned cvtpk(float lo, float hi) { unsigned r; asm volatile("v_cvt_pk_bf16_f32 %0, %1, %2" : "=v"(r) : "v"(lo), "v"(hi)); return r; }
__device__ __forceinline__ bf16x8 load8(const bf16* p) { return *reinterpret_cast<const bf16x8*>(p); }

__device__ __forceinline__ void bias_mask_tile(f32x16& p0, f32x16& p1, int dq, const float* lut) {
    const float NEG = -__builtin_inff();
#pragma unroll
    for (int r = 0; r < 16; ++r) {
        const int c = (r & 3) + 8 * (r >> 2);
        const int d0 = dq - c, d1 = dq - c - 32;
        const float b0 = lut[d0 < 0 ? 0 : (d0 > 127 ? 127 : d0)], b1 = lut[d1 < 0 ? 0 : (d1 > 127 ? 127 : d1)];
        p0[r] = d0 < 0 ? NEG : p0[r] + b0;
        p1[r] = d1 < 0 ? NEG : p1[r] + b1;
        if ((r & 3) == 3) asm volatile("" ::: "memory");
    }
}
__device__ __forceinline__ void partialSM(f32x16& p0, f32x16& p1, float& m_reg, float& mn, float& alpha, bool on) {
    float pmax = p0[0]; for (int r = 1; r < 16; ++r) pmax = fmaxf(pmax, p0[r]); for (int r = 0; r < 16; ++r) pmax = fmaxf(pmax, p1[r]);
    { auto rr = __builtin_amdgcn_permlane32_swap(__float_as_uint(pmax), __float_as_uint(pmax), false, false);
      pmax = fmaxf(__uint_as_float(rr[0]), __uint_as_float(rr[1])); }
    pmax = on ? pmax : -__builtin_inff();
    constexpr float C2 = 1.4426950408889634f * SCALE;
    if (__builtin_expect(__all((pmax - m_reg) * SCALE <= THR), 1)) { mn = m_reg; alpha = 1.f; }
    else { mn = fmaxf(m_reg, pmax); alpha = __builtin_amdgcn_exp2f((m_reg - mn) * C2); m_reg = mn; }
    const float mnL = on ? -mn * C2 : -__builtin_inff();
    for (int r = 0; r < 16; ++r) p0[r] = fmaf(p0[r], C2, mnL); for (int r = 0; r < 16; ++r) p1[r] = fmaf(p1[r], C2, mnL);
    for (int r = 0; r < 16; ++r) p0[r] = __builtin_amdgcn_exp2f(p0[r]);
}
__device__ __forceinline__ void finishSM(f32x16& p0, f32x16& p1, float alpha, float& l_reg, bf16x8& pa0, bf16x8& pa1, bf16x8& pa2, bf16x8& pa3) {
    for (int r = 0; r < 16; ++r) p1[r] = __builtin_amdgcn_exp2f(p1[r]);
    float ps = 0; for (int r = 0; r < 16; ++r) ps += p0[r]; for (int r = 0; r < 16; ++r) ps += p1[r];
    { auto rr = __builtin_amdgcn_permlane32_swap(__float_as_uint(ps), __float_as_uint(ps), false, false);
      ps = __uint_as_float(rr[0]) + __uint_as_float(rr[1]); }
    l_reg = l_reg * alpha + ps;
#define PK4(P, B_, OUT) do { unsigned a0 = cvtpk(P[B_+0], P[B_+1]), a1 = cvtpk(P[B_+2], P[B_+3]);                          \
        unsigned b0 = cvtpk(P[B_+4], P[B_+5]), b1 = cvtpk(P[B_+6], P[B_+7]);                                             \
        auto r0 = __builtin_amdgcn_permlane32_swap(a0, b0, false, false); auto r1 = __builtin_amdgcn_permlane32_swap(a1, b1, false, false); \
        u32x4 w = {r0[0], r1[0], r0[1], r1[1]}; OUT = *reinterpret_cast<bf16x8*>(&w); } while (0)
    PK4(p0, 0, pa0); PK4(p0, 8, pa1); PK4(p1, 0, pa2); PK4(p1, 8, pa3);
#undef PK4
}
template <int KB>
__device__ __forceinline__ void qkt(f32x16& p0, f32x16& p1, const char* K_lds, int r32, int hi, const bf16x8* qr) {
    p0 = f32x16{}; p1 = f32x16{};
    const char* kb[4];
#pragma unroll
    for (int dd = 0; dd < 4; ++dd) kb[dd] = K_lds + KB * SHM_K + KSWZ(r32, (dd * 16 + hi * 8) * 2);
#pragma unroll
    for (int d0 = 0; d0 < 8; ++d0) { const char* a = kb[d0 & 3] + (d0 >> 2) * 128;
        bf16x8 b0 = *reinterpret_cast<const bf16x8*>(a);
        bf16x8 b1 = *reinterpret_cast<const bf16x8*>(a + 32 * 256);
        p0 = __builtin_amdgcn_mfma_f32_32x32x16_bf16(b0, qr[d0], p0, 0, 0, 0);
        p1 = __builtin_amdgcn_mfma_f32_32x32x16_bf16(b1, qr[d0], p1, 0, 0, 0); }
}
template <int VB>
__device__ __forceinline__ void pv_tile(f32x16* o, int vb0, bf16x8 pa0, bf16x8 pa1, bf16x8 pa2, bf16x8 pa3) {
#define TRRD(dst, off) asm volatile("ds_read_b64_tr_b16 %0, %1 offset:%2" : "=&v"(dst) : "v"(vb0), "i"(off) : "memory")
#define PV_D0(d0) do { s16x4 l0, l1, l2, l3, h0, h1, h2, h3; constexpr int b_ = VB * SHM_V + v_rd_off(d0, 0, 0);     \
        TRRD(l0, b_); TRRD(h0, b_ + 2048); TRRD(l1, b_ + 4096); TRRD(h1, b_ + 6144); TRRD(l2, b_ + 8192); TRRD(h2, b_ + 10240); TRRD(l3, b_ + 12288); TRRD(h3, b_ + 14336); \
        asm volatile("s_waitcnt lgkmcnt(0)" ::: "memory"); SBAR();                 \
        o[d0] = __builtin_amdgcn_mfma_f32_32x32x16_bf16(pa0, (bf16x8){l0[0], l0[1], l0[2], l0[3], h0[0], h0[1], h0[2], h0[3]}, o[d0], 0, 0, 0);   \
        o[d0] = __builtin_amdgcn_mfma_f32_32x32x16_bf16(pa1, (bf16x8){l1[0], l1[1], l1[2], l1[3], h1[0], h1[1], h1[2], h1[3]}, o[d0], 0, 0, 0);   \
        o[d0] = __builtin_amdgcn_mfma_f32_32x32x16_bf16(pa2, (bf16x8){l2[0], l2[1], l2[2], l2[3], h2[0], h2[1], h2[2], h2[3]}, o[d0], 0, 0, 0);   \
        o[d0] = __builtin_amdgcn_mfma_f32_32x32x16_bf16(pa3, (bf16x8){l3[0], l3[1], l3[2], l3[3], h3[0], h3[1], h3[2], h3[3]}, o[d0], 0, 0, 0); } while (0)
    PV_D0(0); PV_D0(1); PV_D0(2); PV_D0(3);
#undef PV_D0
#undef TRRD
}

struct BlockRef { const bf16* Q; const bf16* K; const bf16* V; bf16* O; const float* lut; const unsigned short* sel; int ldq, ldkv, ldo, P0, nkt; };
struct Seam { bf16x8 qr[8]; bf16x8 st_v0, st_v1, st_k0, st_k1; };
#define ROWK(p, k0, rr) ((p) + (size_t)((k0) + (rr)) * ldkv + sc)
#define VMW() asm volatile("s_waitcnt vmcnt(0)" ::: "memory")
#define VMWN(n) asm volatile("s_waitcnt vmcnt(%0)" :: "i"(n) : "memory")
#define SLOAD_H(Kp, Vp, k0) do { S.st_v0 = load8(ROWK(Vp, k0, sr)); S.st_v1 = load8(ROWK(Vp, k0, 32 + sr)); S.st_k0 = load8(ROWK(Kp, k0, sr)); S.st_k1 = load8(ROWK(Kp, k0, 32 + sr)); } while (0)
#define SWRITE_HK(bf) do { *(bf16x8*)(K_lds + (bf) * SHM_K + kws) = S.st_k0; *(bf16x8*)(K_lds + (bf) * SHM_K + kws + 32 * 256) = S.st_k1; } while (0)
#define SWRITE_HV(bf) do { *(bf16x8*)(V_lds + (bf) * SHM_V + vst0) = S.st_v0; *(bf16x8*)(V_lds + (bf) * SHM_V + vst1) = S.st_v1; } while (0)
#define SWRITE_H(bf) do { SWRITE_HV(bf); SWRITE_HK(bf); } while (0)
__device__ __forceinline__ void attn_prime(const BlockRef& cur, char* lds, Seam& S, const int tid) {
    const int wid = __builtin_amdgcn_readfirstlane(tid >> 6), lane = tid & 63, r32 = lane & 31, hi = lane >> 5;
    const int sr = tid >> 4, sc = (tid & 15) * 8, kws = KSWZ(sr, sc * 2); char* K_lds = lds + 2 * SHM_V; const int ldkv = cur.ldkv;
    float* lutl = (float*)(lds + LDS_LUT_OFF);
    for (int d0 = 0; d0 < 8; ++d0) S.qr[d0] = load8(cur.Q + (size_t)(wid * QBLK + r32) * cur.ldq + d0 * 16 + hi * 8);
    SLOAD_H(cur.K, cur.V, 0);
    if (tid < 128) lutl[tid] = cur.lut ? cur.lut[tid] : 0.f;
    VMW(); SWRITE_HK(0);
    __syncthreads();
}
template <bool MASK, class MK>
__device__ __forceinline__ void attn_block(const BlockRef& cur, const int nidx, const MK& mk, char* lds, Seam& S, const int tid) {
    const int wid = __builtin_amdgcn_readfirstlane(tid >> 6), lane = tid & 63, r32 = lane & 31, hi = lane >> 5;
    const int NT = cur.nkt;
    const int qlo = cur.P0 + wid * QBLK, qm = qlo + r32 - 4 * hi;
    char* V_lds = lds; char* K_lds = lds + 2 * SHM_V;
    float* ws = (float*)(lds + LDS_WS_OFF) + wid * 64; float* li_l = ws, * al_l = ws + 32;
    float* lutl = (float*)(lds + LDS_LUT_OFF);
    float m_reg = -1e30f, l_reg = 0; f32x16 o[4] = {};
    const int sr = tid >> 4, sc = (tid & 15) * 8, vst0 = v_st(sr, sc), vst1 = v_st(32 + sr, sc), kws = KSWZ(sr, sc * 2);
    const int vb0 = (int)(uintptr_t)V_lds + v_rd_base(lane);
    const bf16* Kh = cur.K; const bf16* Vh = cur.V; const int ldkv = cur.ldkv;
    const unsigned selq = (MASK && cur.sel) ? (unsigned)cur.sel[wid * QBLK + r32] : 0xffffu;
    const int ownb = cur.P0 >> 8;
#define RESC(a) do { if (__any((a) < 1.f)) { if (hi == 0) al_l[r32] = (a); asm volatile("s_waitcnt lgkmcnt(0)" ::: "memory");              \
                     for (int d_ = 0; d_ < 4; ++d_) for (int r = 0; r < 16; ++r) o[d_][r] *= al_l[crow(r, hi)]; } } while (0)
#define KBASE(t) ((t) * KVBLK)
#define MASKT(P0_, P1_, t) do { if constexpr (MASK) { const int kb_ = KBASE(t); if (__builtin_expect(kb_ + KVBLK + 112 > qlo, 0)) bias_mask_tile(P0_, P1_, qm - kb_, lutl); } } while (0)
#define LANE_ON(t) (!MASK || (((t) >> 2) >= ownb) || ((selq >> ((t) >> 2)) & 1u))
    constexpr int NQL = 8;
#define SEAM_K0() do { VMWN(NQL); SWRITE_HK(0); SBAR(); } while (0)
    f32x16 pA0, pA1, pB0, pB1; float mnA, mnB, alA, alB; bf16x8 pa0, pa1, pa2, pa3;
    SWRITE_HV(0); SBAR();
    SLOAD_H(Kh, Vh, KBASE(1));
    SBAR(); qkt<0>(pA0, pA1, K_lds, r32, hi, S.qr);
    MASKT(pA0, pA1, 0); partialSM(pA0, pA1, m_reg, mnA, alA, LANE_ON(0));
    VMW(); SWRITE_H(1);
    __syncthreads();
#define HALF_STEP(PX0, PX1, mnX, alX, PY0, PY1, alY, t, KB, VB, SB) do {                                                      \
        SBAR(); qkt<KB>(PX0, PX1, K_lds, r32, hi, S.qr);                                                                      \
        finishSM(PY0, PY1, alY, l_reg, pa0, pa1, pa2, pa3); SBAR();                                                           \
        if ((t) + 1 < NT) { SLOAD_H(Kh, Vh, KBASE((t) + 1)); SBAR(); }                                                        \
        pv_tile<VB>(o, vb0, pa0, pa1, pa2, pa3); MASKT(PX0, PX1, (t)); partialSM(PX0, PX1, m_reg, mnX, alX, LANE_ON(t));      \
        __syncthreads();                                                                                                      \
        if ((t) + 1 < NT) { VMW(); SWRITE_H(SB); }                                                                            \
        RESC(alX); __syncthreads(); } while (0)
    for (int t = 1; t + 1 < NT; t += 2) {
        HALF_STEP(pB0, pB1, mnB, alB, pA0, pA1, alA, t, 1, 0, 0);
        HALF_STEP(pA0, pA1, mnA, alA, pB0, pB1, alB, t + 1, 0, 1, 1);
    }
    SBAR(); qkt<1>(pB0, pB1, K_lds, r32, hi, S.qr); SBAR();
    const BlockRef nxt = nidx < 0 ? cur : mk(nidx);
    { const int ldkv = nxt.ldkv; SLOAD_H(nxt.K, nxt.V, 0); } SBAR();
#pragma unroll
    for (int d0 = 0; d0 < 8; ++d0) S.qr[d0] = load8(nxt.Q + (size_t)(wid * QBLK + r32) * nxt.ldq + d0 * 16 + hi * 8);
    SBAR();
    finishSM(pA0, pA1, alA, l_reg, pa0, pa1, pa2, pa3); SBAR();
    pv_tile<0>(o, vb0, pa0, pa1, pa2, pa3);
    MASKT(pB0, pB1, NT - 1); partialSM(pB0, pB1, m_reg, mnB, alB, LANE_ON(NT - 1)); __syncthreads(); RESC(alB);
    finishSM(pB0, pB1, alB, l_reg, pa0, pa1, pa2, pa3); SBAR(); pv_tile<1>(o, vb0, pa0, pa1, pa2, pa3);
    SBAR(); SEAM_K0();
    if (hi == 0) li_l[r32] = l_reg; asm volatile("s_waitcnt lgkmcnt(0)" ::: "memory");
    float rli[16];
#pragma unroll
    for (int r = 0; r < 16; ++r) rli[r] = __builtin_amdgcn_rcpf(li_l[crow(r, hi)]);
    const bool is8 = MASK && cur.sel != nullptr;
    const int esz = is8 ? 1 : 2; const float osc = is8 ? 16.0f : 1.0f;
    unsigned char* Ob = (unsigned char*)cur.O + (size_t)(wid * QBLK) * cur.ldo * esz;
    const bool st_on = is8 ? ((r32 & 3) == 0) : ((r32 & 1) == 0);
#pragma unroll
    for (int r = 0; r < 16; ++r) { const int orow = crow(r, hi); const float sc = rli[r] * osc;
        unsigned char* rowp = Ob + (size_t)orow * cur.ldo * esz + r32 * esz;
#pragma unroll
        for (int d0 = 0; d0 < 4; ++d0) { const float v = o[d0][r] * sc;
            const float vn = __shfl_xor(v, 1);
            unsigned b = (unsigned)__builtin_amdgcn_cvt_pk_fp8_f32(v, vn, 0, false) & 0xffffu;
            b |= (unsigned)__shfl_xor((int)b, 2) << 16;
            const unsigned w = is8 ? b : cvtpk(v, vn);
            if (st_on) *(unsigned*)(rowp + d0 * 32 * esz) = w; } }
    if (MASK && tid < 128) lutl[tid] = nxt.lut ? nxt.lut[tid] : 0.f;
    __syncthreads();
#undef RESC
#undef KBASE
#undef MASKT
#undef LANE_ON
#undef SEAM_K0
#undef HALF_STEP
}
#undef ROWK
#undef VMW
#undef VMWN
#undef SLOAD_H
#undef SWRITE_HK
#undef SWRITE_HV
#undef SWRITE_H
#undef KSWZ
#undef SBAR
}
constexpr int NWAVES = 8;
constexpr int NBATCH = 2, SEQ = 4096, DM = 2048, T = NBATCH * SEQ;
constexpr int NQKV = 10240, LDQKV = NQKV + 128  , C_QA = 0, C_KA = 1024, C_VA = 2048, C_QB = 3072, C_KB = 4096, C_VB = 5120, C_GA = 6144, C_GB = 8192;
constexpr int MEMLEN = 256, NEXP = 32, TOPK = 4, CAP = 8192, MAXROWS = 40960;
constexpr float NORM_EPS = 1e-5f;
constexpr int LD8 = 2048 + 128, OMP = 1024 + 128;
constexpr int N_PHASES = 15;
#ifndef MK_ONE_LAUNCH
#define MK_ONE_LAUNCH 1
#endif

constexpr size_t MiB = 1u << 20;
constexpr size_t WS_CTL = 0, CTL_ZERO_BYTES = 128 * 1024;
constexpr size_t WS_LUT = 1 * MiB, WS_TOK = 2 * MiB, WS_CW = 3 * MiB, WS_TSEL = 4 * MiB, WS_SEL = 4 * MiB + 512 * 1024, WS_KMEAN = 5 * MiB, WS_SS = 7 * MiB, WS_WRH = 6 * MiB, WS_WRL = 6 * MiB + 256 * 1024;
constexpr size_t WS_WIN = 8 * MiB, WS_WBM = 48 * MiB, WS_WBD = 52 * MiB, WS_WMIX = 56 * MiB, WS_WXQ = 64 * MiB, WS_WXKV = 66 * MiB, WS_WXO = 70 * MiB, WS_WGU = 72 * MiB, WS_WDN = 584 * MiB;
constexpr size_t WS_H = 840 * MiB, WS_MEMN = 872 * MiB, WS_QKV = 1700 * MiB, WS_OM = 1034 * MiB, WS_ODP = 1050 * MiB, WS_ODN = 1082 * MiB, WS_T1 = 1098 * MiB, WS_MRG = 1130 * MiB;
constexpr size_t WS_H8 = 1162 * MiB, WS_W8 = 1194 * MiB, WS_X1 = 1162 * MiB, WS_HX = 1226 * MiB, WS_QX = 1258 * MiB, WS_KVX = 1266 * MiB, WS_OX = 1268 * MiB, WS_X2 = 1276 * MiB, WS_HF = 1340 * MiB, WS_ACT = 1372 * MiB, WS_Y = 1532 * MiB, WS_END = 1864 * MiB;
constexpr int CW_TMO = 0, CW_BAR = 4096, CW_CNT = 16384;
static_assert((CW_CNT + 64 * NEXP) * 4 <= (int)CTL_ZERO_BYTES, "CTL words inside the memset region");

constexpr int RING_OFF = 0, RING_BYTES = 135168;
constexpr int LDSCTL_OFF = RING_BYTES, TAB_OFF = LDSCTL_OFF, MISC_OFF = LDSCTL_OFF + 1024;
constexpr int LDS_BYTES = 147456;
static_assert(MISC_OFF + 128 <= LDS_BYTES && att::LDS_BYTES <= RING_BYTES && pg8::STAGE_BYTES <= RING_BYTES, "LDS map");

#define GAS __attribute__((address_space(1)))
#define LAS __attribute__((address_space(3)))
typedef unsigned short bf16;
typedef unsigned v4u __attribute__((ext_vector_type(4)));
typedef unsigned v2u __attribute__((ext_vector_type(2)));
typedef float f32x4 __attribute__((ext_vector_type(4)));
typedef GAS unsigned gu32;
#define RLX_AGENT __ATOMIC_RELAXED, __HIP_MEMORY_SCOPE_AGENT
#define LDS_WAIT() asm volatile("s_waitcnt lgkmcnt(0)" ::: "memory")
#define VM_WAIT() asm volatile("s_waitcnt vmcnt(0)" ::: "memory")
__device__ __forceinline__ unsigned f2bf(float f) { unsigned u = __builtin_bit_cast(unsigned, f); return (u + 0x7fffu + ((u >> 16) & 1u)) >> 16; }
__device__ __forceinline__ unsigned pk2(float lo, float hi) { return f2bf(lo) | (f2bf(hi) << 16); }
__device__ __forceinline__ float bflo(unsigned w) { return __builtin_bit_cast(float, w << 16); }
__device__ __forceinline__ float bfhi(unsigned w) { return __builtin_bit_cast(float, w & 0xffff0000u); }

#define XB_TMO      128
#define XB_XCNT(j)  (256  + 64 * (j))
#define XB_XSUB(j)  (1280 + 64 * (j))
#define XB_XGEN(j)  (2304 + 64 * (j))
#define XB_TOP      3328
#define XB_TOPGEN   3392
#define XCD_BAR_WORDS 3456
#define XB_SPIN_CAP (1u << 18)
__device__ __forceinline__ unsigned xb_ld(unsigned* p)              { return __hip_atomic_load(p, __ATOMIC_RELAXED, __HIP_MEMORY_SCOPE_AGENT); }
__device__ __forceinline__ unsigned xb_add(unsigned* p, unsigned v) { return __hip_atomic_fetch_add(p, v, __ATOMIC_RELAXED, __HIP_MEMORY_SCOPE_AGENT); }
__device__ __forceinline__ unsigned xb_xcc_id() { return (unsigned)__builtin_amdgcn_s_getreg((3 << 11) | 20) & 0xFu; }
#define XB_SPIN(cond, bar) do { unsigned _sp = 0; while (cond) { __builtin_amdgcn_s_sleep(1); \
    if ((++_sp & 255u) == 0u) { if (xb_ld(&(bar)[XB_TMO])) break; if (_sp > XB_SPIN_CAP) { atomicAdd(&(bar)[XB_TMO], 1u); break; } } } } while (0)
struct XcdBarrier { unsigned* bar; unsigned x; volatile LAS unsigned* st; };
__device__ __forceinline__ XcdBarrier xcd_barrier_post(unsigned* bar, volatile LAS unsigned* st, const bool t0) {
    XcdBarrier b; b.bar = bar; b.x = xb_xcc_id(); b.st = st;
    if (t0) (void)xb_add(&bar[XB_XCNT(b.x)], 1u);
    return b;
}
__device__ __forceinline__ void xcd_barrier_complete(unsigned* bar, unsigned x, unsigned& nloc, unsigned& nx) {
    const unsigned G = gridDim.x * gridDim.y * gridDim.z;
    unsigned sum, cnt, mine, sp = 0u;
    for (;;) {
        sum = 0u; cnt = 0u; mine = 0u;
#pragma unroll
        for (unsigned j = 0; j < 16; ++j) { const unsigned c = xb_ld(&bar[XB_XCNT(j)]); sum += c; cnt += (c > 0u) ? 1u : 0u; mine = (j == x) ? c : mine; }
        if (sum == G) break;
        __builtin_amdgcn_s_sleep(1);
        if ((++sp & 255u) == 0u) { if (xb_ld(&bar[XB_TMO])) break; if (sp > XB_SPIN_CAP) { atomicAdd(&bar[XB_TMO], 1u); break; } }
    }
    nloc = mine > 0u ? mine : 1u; nx = cnt > 0u ? cnt : 1u;
}
__device__ __forceinline__ void xcd_barrier(const XcdBarrier& b, const bool t0) {
    asm volatile("s_waitcnt vmcnt(0)" ::: "memory");
    __syncthreads();
    if (t0) {
        unsigned* bar = b.bar;
        __builtin_amdgcn_s_waitcnt(0);
        unsigned nloc = b.st[0], nx = b.st[1];
        if (nloc == 0u) { xcd_barrier_complete(bar, b.x, nloc, nx); b.st[0] = nloc; b.st[1] = nx; }
        const unsigned old = xb_add(&bar[XB_XSUB(b.x)], 1u);
        const unsigned gen = old / nloc;
        if (old + 1u == (gen + 1u) * nloc) {
            __builtin_amdgcn_fence(__ATOMIC_RELEASE, "agent");
            asm volatile("s_waitcnt vmcnt(0)" ::: "memory");
            const unsigned og = xb_add(&bar[XB_TOP], 1u);
            const unsigned tg = og / nx;
            if (og + 1u == (tg + 1u) * nx) xb_add(&bar[XB_TOPGEN], 1u);
            else XB_SPIN(xb_ld(&bar[XB_TOPGEN]) == tg, bar);
            __builtin_amdgcn_fence(__ATOMIC_ACQUIRE, "agent");
            xb_add(&bar[XB_XGEN(b.x)], 1u);
            asm volatile("s_waitcnt vmcnt(0)" ::: "memory");
        } else {
            XB_SPIN(xb_ld(&bar[XB_XGEN(b.x)]) == gen, bar);
            __builtin_amdgcn_fence(__ATOMIC_ACQUIRE, "agent");
            asm volatile("s_waitcnt vmcnt(0)" ::: "memory");
        }
    }
    __syncthreads();
}

struct Args { const float* in[27]; float* out; unsigned char* ws; int ph_lo, ph_hi; };
struct Frame {
    LAS unsigned char* lds; char* ldsg;
    volatile LAS unsigned* MISC;
    unsigned* ctl;
    int tid, lane, wave, vcu, G;
};
__device__ __forceinline__ int lane_now() { int l; asm volatile("v_mbcnt_lo_u32_b32 %0, -1, 0\n\tv_mbcnt_hi_u32_b32 %0, -1, %0" : "=v"(l)); return l; }
#define RETID() do { F.lane = lane_now(); F.tid = F.wave * 64 + F.lane; } while (0)
__device__ __forceinline__ float wave_sum(float v) {
#pragma unroll
    for (int o = 1; o < 64; o <<= 1) v += __shfl_xor(v, o);
    return v;
}
__device__ __forceinline__ void rms_row_to_bf16(int lane, const float* xrow, const float* gain, bf16* orow, unsigned char* o8row = nullptr) {
    const GAS f32x4* xr = (const GAS f32x4*)xrow + lane; const GAS f32x4* gr = (const GAS f32x4*)gain + lane;
    f32x4 v[8]; float s2 = 0.f;
#pragma unroll
    for (int j = 0; j < 8; ++j) { v[j] = xr[64 * j]; s2 += (v[j].x * v[j].x + v[j].y * v[j].y) + (v[j].z * v[j].z + v[j].w * v[j].w); }
    const float rstd = 1.f / sqrtf(wave_sum(s2) * (1.f / DM) + NORM_EPS);
    GAS unsigned long long* o8 = (GAS unsigned long long*)orow + lane;
#pragma unroll
    for (int j = 0; j < 8; ++j) { const f32x4 gv = gr[64 * j];
        o8[64 * j] = (unsigned long long)pk2(v[j].x * rstd * gv.x, v[j].y * rstd * gv.y) | ((unsigned long long)pk2(v[j].z * rstd * gv.z, v[j].w * rstd * gv.w) << 32);
        if (o8row) ((GAS unsigned*)o8row)[lane + 64 * j] = pg8::pk4_fp8(v[j].x * rstd * gv.x, v[j].y * rstd * gv.y, v[j].z * rstd * gv.z, v[j].w * rstd * gv.w); }
}
__device__ __forceinline__ int rel_bucket(int d) {
    if (d < 16) return d;
    const int l = 16 + (int)(logf((float)d * (1.0f / 16.0f)) / 2.0794415416798357f * 16.0f);
    return l < 31 ? l : 31;
}
__device__ __forceinline__ void moe_tables(Frame& F) {
    LAS int* tab = (LAS int*)(F.lds + TAB_OFF);
    if (F.tid < 32) tab[64 + F.tid] = (int)__hip_atomic_load(F.ctl + CW_CNT + 64 * F.tid, RLX_AGENT);
    __syncthreads();
    if (F.tid == 0) { int acc = 0; for (int e = 0; e < 32; ++e) { tab[e] = acc; acc += (tab[64 + e] + 255) >> 8; } tab[32] = acc; }
    __syncthreads();
}


typedef const __attribute__((address_space(4))) Args* KArgs;
__device__ __forceinline__ KArgs kargs() { unsigned long long p = (unsigned long long)__builtin_amdgcn_kernarg_segment_ptr(); asm volatile("" : "+s"(p)); return (KArgs)p; }
#define AIN(k) (kargs()->in[k])
struct TrDesc { const float* src; unsigned char* dst; const float* rs; int K, N, f8, ld; };
constexpr int TI_IN = 32 * 48  , TI_BM = 16 * 32, TI_BM8 = 8 * 32  , TI_MIX = 32 * 32, TI_XQ = 16 * 8  , TI_XO = 8 * 32, TI_GU = 16 * 64, TI_DN = 16 * 32;
constexpr int TI_SMALL = TI_IN + TI_BM8 + TI_BM + TI_MIX + 3 * TI_XQ + TI_XO, TI_TOTAL = TI_SMALL + 32 * (TI_GU + TI_DN);
constexpr int TI_W8E = 16 * 48  ; constexpr int CW_GATE = 8192  ;
constexpr int TI_W8 = 16 * 112;
constexpr int TI_SM = TI_SMALL - TI_IN;
constexpr int TI_P10 = 128 * 8 * 2;
constexpr int TI_DEFER = 184 * 8 * 5;
constexpr int P4_ATT_CUS = 224, TI_P4M = 32 * 8 * 34, TI_P4 = TI_SM + TI_P4M, TI_S0 = TI_TOTAL - TI_DEFER - TI_P10 - TI_P4;
constexpr int P1_GEMM_CUS = 160;
constexpr int TR_PITCH = 160, TR_LDS_PER_WAVE = 64 * TR_PITCH;
__device__ __forceinline__ TrDesc tr_make(const float* W, int K, int N, void* WT, int row_off, int item, int f8 = 0, const float* rs = nullptr, int ld = 0) {
    const int nblk = N / 64, kb = item / nblk, nb = item % nblk, k0 = (f8 ? 128 : 64) * kb, n0 = 64 * nb;
    TrDesc d; d.src = W + (size_t)k0 * N + n0; d.ld = ld ? ld : K * (f8 ? 1 : 2); d.dst = (unsigned char*)WT + (size_t)(row_off + n0) * d.ld + (size_t)k0 * (f8 ? 1 : 2); d.K = K; d.N = N; d.f8 = f8; d.rs = rs ? rs + k0 : nullptr; return d;
}
__device__ __forceinline__ TrDesc tr_decode(int it, unsigned char* ws) {
    int r = it;
    if (r >= TI_TOTAL) { r -= TI_TOTAL; const int kb = r < TI_W8E ? r / 48 : (r - TI_W8E) / 64, nb = r < TI_W8E ? r % 48 : 48 + (r - TI_W8E) % 64, j = nb >> 2, gpn = j < 12 ? j : 12 + j;
        TrDesc d; d.src = AIN(4) + (size_t)(128 * kb) * NQKV + gpn * 256 + (nb & 3) * 64; d.ld = LD8; d.dst = (unsigned char*)(ws + WS_W8) + (size_t)(64 * nb) * LD8 + 128 * kb; d.K = 2048; d.N = NQKV; d.f8 = 1; d.rs = nullptr; return d; }
    if (r < TI_IN) { const int kb = r / 48, nl = r % 48, jl = nl >> 2, nb = (12 + jl) * 4 + (nl & 3);
        TrDesc d; d.src = AIN(4) + (size_t)(64 * kb) * NQKV + 64 * nb; d.ld = 4096; d.dst = (unsigned char*)(ws + WS_WIN) + (size_t)(64 * nb) * 4096 + 128 * kb; d.K = 2048; d.N = NQKV; d.f8 = 0; d.rs = nullptr; return d; }
    r -= TI_IN;
    if (r >= TI_S0 - TI_IN && r < TI_S0 - TI_IN + TI_SM) r -= TI_S0 - TI_IN; else r = TI_SM + (r >= TI_S0 - TI_IN ? r - TI_SM : r);
    if (r < TI_BM8) return tr_make(AIN(10), 1024, 2048, (unsigned char*)(ws + WS_WBM), 0, r, 1, nullptr, OMP); r -= TI_BM8;
    if (r < TI_BM) return tr_make(AIN(11), 1024, 2048, (bf16*)(ws + WS_WBD), 0, r); r -= TI_BM;
    if (r < TI_MIX) return tr_make(AIN(12), 2048, 2048, (bf16*)(ws + WS_WMIX), 0, r); r -= TI_MIX;
    if (r < TI_XQ) return tr_make(AIN(15), 2048, 512, (unsigned char*)(ws + WS_WXQ), 0, r, 1, nullptr, LD8); r -= TI_XQ;
    if (r < TI_XQ) return tr_make(AIN(16), 2048, 512, (unsigned char*)(ws + WS_WXKV), 0, r, 1, nullptr, LD8); r -= TI_XQ;
    if (r < TI_XQ) return tr_make(AIN(17), 2048, 512, (unsigned char*)(ws + WS_WXKV), 512, r, 1, nullptr, LD8); r -= TI_XQ;
    if (r < TI_XO) return tr_make(AIN(18), 512, 2048, (bf16*)(ws + WS_WXO), 0, r); r -= TI_XO;
    if (r < 32 * TI_GU) { const int e = r / TI_GU; return tr_make(AIN(22) + (size_t)e * 2048 * 4096, 2048, 4096, (unsigned char*)(ws + WS_WGU) + (size_t)e * 4096 * LD8, 0, r % TI_GU, 1, nullptr, LD8); } r -= 32 * TI_GU;
    const int e = r / TI_DN; return tr_make(AIN(24) + (size_t)e * 2048 * 2048, 2048, 2048, (unsigned char*)(ws + WS_WDN) + (size_t)e * 2048 * LD8, 0, r % TI_DN, 1, nullptr, LD8);
}
typedef short v4i16_t __attribute__((ext_vector_type(4)));
__device__ __forceinline__ v2u tr_rd(const LAS unsigned char* p) { return __builtin_bit_cast(v2u, __builtin_amdgcn_ds_read_tr16_b64_v4i16((LAS v4i16_t*)p)); }
__device__ __forceinline__ unsigned cvtpk_hw(float lo, float hi) { unsigned r; asm volatile("v_cvt_pk_bf16_f32 %0, %1, %2" : "=v"(r) : "v"(lo), "v"(hi)); return r; }
template <bool ALLOW8>
__device__ __forceinline__ void tr_run(int first, int stride, int end, unsigned char* ws, LAS unsigned char* scr, int lane) {
    const int l16 = lane & 15, g = lane >> 4, q4 = l16 >> 2, p4 = l16 & 3, godd = g & 1;
    LAS unsigned char* wr = scr + (lane >> 4) * TR_PITCH + l16 * 8;
    const LAS unsigned char* rdA = scr + (q4 + 12 * godd) * TR_PITCH + (16 * (g >> 1) + 4 * p4) * 2;
    const LAS unsigned char* rdB = scr + (q4 + 4 + 4 * godd) * TR_PITCH + (16 * (g >> 1) + 4 * p4) * 2;
    constexpr int OP = 144;
    for (int it = first; it < end; it += stride) {
        const TrDesc d = tr_decode(it, ws);
        if (ALLOW8 && d.f8) {
            TrDesc dc = d; int itc = it;
            const unsigned rdA_ = (unsigned)(uintptr_t)rdA, rdB_ = (unsigned)(uintptr_t)rdB;
            f32x4 vA[16], vB[16];
#define TR_LD16(V, D, K0) do { const unsigned vo_ = (unsigned)(((lane >> 4) * (D).N + 4 * l16) * 4); const char* rb_ = (const char*)((D).src + (size_t)(K0) * (D).N); const size_t rs_ = (size_t)(D).N * 16; \
                _Pragma("unroll") for (int i = 0; i < 16; ++i) V[i] = *(const GAS f32x4*)(rb_ + i * rs_ + vo_); } while (0)
            TR_LD16(vA, dc, 0);
            for (;;) {
                v2u o[2][2][4];
                TR_LD16(vB, dc, 64);
#define TRRD_(dst, base, off) asm volatile("ds_read_b64_tr_b16 %0, %1 offset:%2" : "=&v"(dst) : "v"(base), "i"(off) : "memory")
#define TR_HALF(V, HK) do { const float sc = pg8::W8_SCALE; \
                _Pragma("unroll") for (int i = 0; i < 16; ++i) { v2u w; w.x = cvtpk_hw(V[i].x * sc, V[i].y * sc); w.y = cvtpk_hw(V[i].z * sc, V[i].w * sc); *(LAS v2u*)(wr + 4 * i * TR_PITCH) = w; } \
                LDS_WAIT(); asm volatile("" ::: "memory"); \
                v2u ta_[2][4], tb_[2][4];   \
                _Pragma("unroll") for (int ps = 0; ps < 2; ++ps) _Pragma("unroll") for (int t = 0; t < 4; ++t) { TRRD_(ta_[ps][t], rdA_, 16 * t * TR_PITCH + ps * 64); TRRD_(tb_[ps][t], rdB_, 16 * t * TR_PITCH + ps * 64); } \
                LDS_WAIT(); __builtin_amdgcn_sched_barrier(0); \
                _Pragma("unroll") for (int ps = 0; ps < 2; ++ps) _Pragma("unroll") for (int t = 0; t < 4; ++t) { \
                    const v2u a = ta_[ps][t], b = tb_[ps][t]; const v2u lo = godd ? b : a, hi = godd ? a : b; \
                    o[HK][ps][t].x = pg8::pk4_fp8(bflo(lo.x), bfhi(lo.x), bflo(lo.y), bfhi(lo.y)); o[HK][ps][t].y = pg8::pk4_fp8(bflo(hi.x), bfhi(hi.x), bflo(hi.y), bfhi(hi.y)); } \
                asm volatile("" ::: "memory"); } while (0)
                TR_HALF(vA, 0);
                const int nit = itc + stride; const bool more = nit < end; TrDesc dn = dc; bool chain = false;
                if (more) { dn = tr_decode(nit, ws); chain = dn.f8 != 0;
                    if (chain) TR_LD16(vA, dn, 0); }
                TR_HALF(vB, 1);
#undef TR_HALF
#undef TRRD_
                LAS unsigned char* ow = scr + (16 * (g >> 1) + l16) * OP + 8 * godd;
#pragma unroll
                for (int hk = 0; hk < 2; ++hk)
#pragma unroll
                    for (int ps = 0; ps < 2; ++ps)
#pragma unroll
                        for (int t = 0; t < 4; ++t) *(LAS v2u*)(ow + 32 * ps * OP + 64 * hk + 16 * t) = o[hk][ps][t];
                LDS_WAIT(); asm volatile("" ::: "memory");
#pragma unroll
                for (int j = 0; j < 8; ++j) { const int row = (lane >> 3) + 8 * j, c = lane & 7;
                    const v4u w = *(const LAS v4u*)(scr + row * OP + 16 * c);
                    *(GAS v4u*)(dc.dst + (size_t)row * dc.ld + 16 * c) = w; }
                LDS_WAIT(); asm volatile("" ::: "memory");
                if (!chain) { it = more ? nit - stride : itc; break; }
                dc = dn; itc = nit; it = nit;
            }
            continue;
        }
        {
            const float* s = d.src + (size_t)(lane >> 4) * d.N + 4 * l16;
            f32x4 v[16];
#pragma unroll
            for (int i = 0; i < 16; ++i) v[i] = *(const GAS f32x4*)(s + (size_t)(4 * i) * d.N);
#pragma unroll
            for (int i = 0; i < 16; ++i) { const float sc = d.rs ? d.rs[(lane >> 4) + 4 * i] : 1.0f; v2u w; w.x = cvtpk_hw(v[i].x * sc, v[i].y * sc); w.y = cvtpk_hw(v[i].z * sc, v[i].w * sc); *(LAS v2u*)(wr + 4 * i * TR_PITCH) = w; }
            LDS_WAIT(); asm volatile("" ::: "memory");
            v4u ob[2][4];
#pragma unroll
            for (int ps = 0; ps < 2; ++ps)
#pragma unroll
                for (int t = 0; t < 4; ++t) {
                    const v2u a = tr_rd(rdA + 16 * t * TR_PITCH + ps * 64), b = tr_rd(rdB + 16 * t * TR_PITCH + ps * 64);
                    ob[ps][t].x = godd ? b.x : a.x; ob[ps][t].y = godd ? b.y : a.y; ob[ps][t].z = godd ? a.x : b.x; ob[ps][t].w = godd ? a.y : b.y; }
            LDS_WAIT(); asm volatile("" ::: "memory");
            LAS unsigned char* ow = scr + (16 * (g >> 1) + l16) * OP + 16 * godd;
#pragma unroll
            for (int ps = 0; ps < 2; ++ps)
#pragma unroll
                for (int t = 0; t < 4; ++t) *(LAS v4u*)(ow + 32 * ps * OP + 32 * t) = ob[ps][t];
            LDS_WAIT(); asm volatile("" ::: "memory");
#pragma unroll
            for (int j = 0; j < 8; ++j) { const int row = (lane >> 3) + 8 * j, c = lane & 7;
                const v4u w = *(const LAS v4u*)(scr + row * OP + 16 * c);
                *(GAS v4u*)(d.dst + (size_t)row * d.ld + 16 * c) = w; }
            LDS_WAIT(); asm volatile("" ::: "memory");
        }
    }
}

__device__ __forceinline__ att::BlockRef mk_self_ref(int idx, bf16* QKV, bf16* OM, bf16* ODP, float* LUT, unsigned short* SEL) {
    att::BlockRef r; const int qb = 15 - idx / 48, hs = idx % 48; r.ldq = LDQKV; r.ldkv = LDQKV; r.P0 = qb * 256; r.nkt = 4 * (qb + 1);
    if (hs < 16) { const int b = hs >> 3, h = hs & 7; const size_t row0 = (size_t)b * SEQ;
        r.Q = QKV + (row0 + qb * 256) * LDQKV + C_QA + h * 128; r.K = QKV + row0 * LDQKV + C_KA + h * 128; r.V = QKV + row0 * LDQKV + C_VA + h * 128;
        r.O = (bf16*)((unsigned char*)OM + (row0 + qb * 256) * OMP + h * 128); r.ldo = OMP;     r.lut = LUT + h * 128; r.sel = SEL + (size_t)(b * 8 + h) * SEQ + qb * 256; }
    else { const int d = hs - 16, b = d >> 4, rem = d & 15, h = rem >> 2, i = (rem >> 1) & 1, vh = rem & 1; const size_t row0 = (size_t)b * SEQ;
        r.Q = QKV + (row0 + qb * 256) * LDQKV + C_QB + (h * 2 + i) * 128; r.K = QKV + row0 * LDQKV + C_KB + (h * 2 + i) * 128; r.V = QKV + row0 * LDQKV + C_VB + h * 256 + vh * 128;
        r.O = ODP + (row0 + qb * 256) * 2048 + ((h * 2 + i) * 2 + vh) * 128; r.ldo = 2048; r.lut = LUT + (8 + h) * 128; r.sel = nullptr; }
    return r;
}
__device__ __forceinline__ att::BlockRef mk_cross_ref(int idx, bf16* QX, bf16* KVX, bf16* OX) {
    att::BlockRef r; const int b = idx >> 6, h = (idx >> 4) & 3, qb = idx & 15; const size_t row0 = (size_t)b * SEQ + qb * 256;
    int l512 = 512, l1024 = 1024; asm volatile("" : "+s"(l512), "+s"(l1024));
    r.Q = QX + row0 * 512 + h * 128; r.ldq = l512; r.K = KVX + (size_t)b * MEMLEN * 1024 + h * 128; r.V = r.K + 512; r.ldkv = l1024;
    r.O = OX + row0 * 512 + h * 128; r.ldo = l512; r.lut = nullptr; r.sel = nullptr; r.P0 = 1 << 20; r.nkt = 4; return r;
}


static_assert(P4_ATT_CUS == 224, "ATT_LPT is dealt for 224 attention workgroups");
__device__ const short ATT_LPT[224 * 4] = {
    0,400,528,-1, 1,401,529,-1, 2,402,530,-1, 3,403,531,-1, 4,404,532,-1, 5,405,533,-1, 6,406,534,-1, 7,407,535,-1,
    8,408,536,-1, 9,409,537,-1, 10,410,538,-1, 11,411,539,-1, 12,412,540,-1, 13,413,541,-1, 14,414,542,-1, 15,415,543,-1,
    16,416,544,-1, 17,417,545,-1, 18,418,546,-1, 19,419,547,-1, 20,420,548,-1, 21,421,549,-1, 22,422,550,-1, 23,423,551,-1,
    24,424,552,-1, 25,425,553,-1, 26,426,554,-1, 27,427,555,-1, 28,428,556,-1, 29,429,557,-1, 30,430,558,-1, 31,431,559,-1,
    32,432,448,-1, 33,433,449,-1, 34,434,450,-1, 35,435,451,-1, 36,436,452,-1, 37,437,453,-1, 38,438,454,-1, 39,439,455,-1,
    40,440,456,-1, 41,441,457,-1, 42,442,458,-1, 43,443,459,-1, 44,444,460,-1, 45,445,461,-1, 46,446,462,-1, 47,447,463,-1,
    48,352,560,-1, 49,353,561,-1, 50,354,562,-1, 51,355,563,-1, 52,356,564,-1, 53,357,565,-1, 54,358,566,-1, 55,359,567,-1,
    56,360,568,-1, 57,361,569,-1, 58,362,570,-1, 59,363,571,-1, 60,364,572,-1, 61,365,573,-1, 62,366,574,-1, 63,367,575,-1,
    64,368,576,720, 65,369,577,721, 66,370,578,722, 67,371,579,723, 68,372,580,724, 69,373,581,725, 70,374,582,726, 71,375,583,727,
    72,376,584,728, 73,377,585,729, 74,378,586,730, 75,379,587,731, 76,380,588,732, 77,381,589,733, 78,382,590,734, 79,383,591,735,
    80,384,464,-1, 81,385,465,-1, 82,386,466,-1, 83,387,467,-1, 84,388,468,-1, 85,389,469,-1, 86,390,470,-1, 87,391,471,-1,
    88,392,472,-1, 89,393,473,-1, 90,394,474,-1, 91,395,475,-1, 92,396,476,-1, 93,397,477,-1, 94,398,478,-1, 95,399,479,-1,
    96,304,592,736, 97,305,593,737, 98,306,594,738, 99,307,595,739, 100,308,596,740, 101,309,597,741, 102,310,598,742, 103,311,599,743,
    104,312,600,744, 105,313,601,745, 106,314,602,746, 107,315,603,747, 108,316,604,748, 109,317,605,749, 110,318,606,750, 111,319,607,751,
    112,320,608,752, 113,321,609,753, 114,322,610,754, 115,323,611,755, 116,324,612,756, 117,325,613,757, 118,326,614,758, 119,327,615,759,
    120,328,616,760, 121,329,617,761, 122,330,618,762, 123,331,619,763, 124,332,620,764, 125,333,621,765, 126,334,622,766, 127,335,623,767,
    128,336,480,-1, 129,337,481,-1, 130,338,482,-1, 131,339,483,-1, 132,340,484,-1, 133,341,485,-1, 134,342,486,-1, 135,343,487,-1,
    136,344,488,-1, 137,345,489,-1, 138,346,490,-1, 139,347,491,-1, 140,348,492,-1, 141,349,493,-1, 142,350,494,-1, 143,351,495,-1,
    144,256,624,672, 145,257,625,673, 146,258,626,674, 147,259,627,675, 148,260,628,676, 149,261,629,677, 150,262,630,678, 151,263,631,679,
    152,264,632,680, 153,265,633,681, 154,266,634,682, 155,267,635,683, 156,268,636,684, 157,269,637,685, 158,270,638,686, 159,271,639,687,
    160,272,640,688, 161,273,641,689, 162,274,642,690, 163,275,643,691, 164,276,644,692, 165,277,645,693, 166,278,646,694, 167,279,647,695,
    168,280,648,696, 169,281,649,697, 170,282,650,698, 171,283,651,699, 172,284,652,700, 173,285,653,701, 174,286,654,702, 175,287,655,703,
    176,288,496,-1, 177,289,497,-1, 178,290,498,-1, 179,291,499,-1, 180,292,500,-1, 181,293,501,-1, 182,294,502,-1, 183,295,503,-1,
    184,296,504,-1, 185,297,505,-1, 186,298,506,-1, 187,299,507,-1, 188,300,508,-1, 189,301,509,-1, 190,302,510,-1, 191,303,511,-1,
    192,224,656,704, 193,225,657,705, 194,226,658,706, 195,227,659,707, 196,228,660,708, 197,229,661,709, 198,230,662,710, 199,231,663,711,
    200,232,664,712, 201,233,665,713, 202,234,666,714, 203,235,667,715, 204,236,668,716, 205,237,669,717, 206,238,670,718, 207,239,671,719,
    208,240,512,-1, 209,241,513,-1, 210,242,514,-1, 211,243,515,-1, 212,244,516,-1, 213,245,517,-1, 214,246,518,-1, 215,247,519,-1,
    216,248,520,-1, 217,249,521,-1, 218,250,522,-1, 219,251,523,-1, 220,252,524,-1, 221,253,525,-1, 222,254,526,-1, 223,255,527,-1,
};
__global__ void __launch_bounds__(NWAVES * 64, 2) fwd(Args args) {
    extern __shared__ __attribute__((aligned(16))) unsigned char lds[];
    Frame F;
    F.lds = (LAS unsigned char*)lds; F.ldsg = (char*)lds;
    F.MISC = (volatile LAS unsigned*)(F.lds + MISC_OFF);
    F.wave = __builtin_amdgcn_readfirstlane((int)threadIdx.x >> 6); RETID();
    F.G = gridDim.x; { const int bx = blockIdx.x; F.vcu = (F.G % 8 == 0) ? (bx % 8) * (F.G / 8) + bx / 8 : bx; }
    unsigned char* ws = args.ws;
    F.ctl = (unsigned*)(ws + WS_CTL);
    for (int u = F.tid; u < (LDS_BYTES - LDSCTL_OFF) / 4; u += NWAVES * 64) ((LAS unsigned*)(F.lds + LDSCTL_OFF))[u] = 0u;
    __syncthreads();
    XcdBarrier bar; bar.bar = F.ctl + CW_BAR; bar.x = 0; bar.st = nullptr;
    const int lo = args.ph_lo, hi = args.ph_hi;
    const bool one = (hi - lo) > 1;
    if (one) bar = xcd_barrier_post(F.ctl + CW_BAR, F.MISC + 8, F.tid == 0);
#ifndef P0PROBE
#define P0PROBE 0
#endif
#ifndef REPMASK
#define REPMASK 0u
#endif
#ifndef PH_MASK
#define PH_MASK 0xFFFFFu
#endif
#define IN(k) ((((PH_MASK) >> (k)) & 1u) && lo <= (k) && (k) < hi)
#ifndef SEAMREP
#define SEAMREP 1
#endif
#define SEAM(k) do { if (IN(k) && IN((k) + 1)) { RETID(); for (int sr_ = 0; sr_ < SEAMREP; ++sr_) xcd_barrier(bar, F.tid == 0); } } while (0)
#define WIN ((bf16*)(ws + WS_WIN))
#define WBM ((bf16*)(ws + WS_WBM))
#define WBD ((bf16*)(ws + WS_WBD))
#define WMIX ((bf16*)(ws + WS_WMIX))
#define WXQ ((bf16*)(ws + WS_WXQ))
#define WXKV ((bf16*)(ws + WS_WXKV))
#define WXO ((bf16*)(ws + WS_WXO))
#define WGU ((bf16*)(ws + WS_WGU))
#define WDN ((bf16*)(ws + WS_WDN))
#define H ((bf16*)(ws + WS_H))
#define MEMN ((bf16*)(ws + WS_MEMN))
#define QKV ((bf16*)(ws + WS_QKV))
#define OM ((bf16*)(ws + WS_OM))
#define ODP ((bf16*)(ws + WS_ODP))
#define ODN ((bf16*)(ws + WS_ODN))
#define T1 ((bf16*)(ws + WS_T1))
#define MRG ((bf16*)(ws + WS_MRG))
#define X1 ((float*)(ws + WS_X1))
#define HX ((bf16*)(ws + WS_HX))
#define H8 ((unsigned char*)(ws + WS_H8))
#define HX8 ((unsigned char*)(ws + 1310 * MiB))
#define MEMN8 ((unsigned char*)(ws + 1332 * MiB))
#define W8 ((unsigned char*)(ws + WS_W8))
#define QX ((bf16*)(ws + WS_QX))
#define KVX ((bf16*)(ws + WS_KVX))
#define OX ((bf16*)(ws + WS_OX))
#define X2 ((bf16*)(ws + WS_X2))
#define HF ((bf16*)(ws + WS_HF))
#define ACT ((bf16*)(ws + WS_ACT))
#define YB ((bf16*)(ws + WS_Y))
#define LUT ((float*)(ws + WS_LUT))
#define TOK ((int*)(ws + WS_TOK))
#define CWT ((float*)(ws + WS_CW))
#define TSEL ((int*)(ws + WS_TSEL))
#define SEL ((unsigned short*)(ws + WS_SEL))
#define KMEAN ((float*)(ws + WS_KMEAN))
#define SSQ ((float*)(ws + WS_SS))
#define WRH ((bf16*)(ws + WS_WRH))
#define WRL ((bf16*)(ws + WS_WRL))
    const int gw = F.vcu * NWAVES + F.wave, NGW = F.G * NWAVES;

    for (int rep_ = IN(0) ? 1 + (int)(((REPMASK) >> 0) & 1u) : 0; rep_ > 0; --rep_) { RETID();
        LAS unsigned char* scr = F.lds + RING_OFF + F.wave * TR_LDS_PER_WAVE;
        tr_run<false>(gw, NGW, TI_IN, ws, scr, F.lane);
        tr_run<true>(TI_TOTAL + gw, NGW, TI_TOTAL + (F.G >= 256 ? TI_W8E : TI_W8), ws, scr, F.lane);
        for (int m = gw; m < T; m += NGW) rms_row_to_bf16(F.lane, AIN(0) + (size_t)m * DM, AIN(3), H + (size_t)m * DM, H8 + (size_t)m * LD8);
        for (int m = gw; m < NBATCH * MEMLEN; m += NGW) rms_row_to_bf16(F.lane, AIN(1) + (size_t)m * DM, AIN(14), MEMN + (size_t)m * DM, MEMN8 + (size_t)m * LD8);
        for (int i = F.vcu * (NWAVES * 64) + F.tid; i < NBATCH * 8 * 16 * 128; i += F.G * NWAVES * 64) KMEAN[i] = 0.f;
        for (int i = F.vcu * (NWAVES * 64) + F.tid; i < 2048 * 32; i += F.G * NWAVES * 64) { const int k = i >> 5, e = i & 31; const float w = AIN(20)[i]; const unsigned hi = f2bf(w); const float rem = w - __builtin_bit_cast(float, hi << 16);
            WRH[(size_t)e * 2048 + k] = (bf16)hi; WRL[(size_t)e * 2048 + k] = (bf16)f2bf(rem); }
        {
            const float* tb = AIN(2);
            for (int i = F.vcu * (NWAVES * 64) + F.tid; i < 12 * 128; i += F.G * NWAVES * 64) { const int h = i >> 7, d = i & 127; LUT[i] = (tb[rel_bucket(d) * 12 + h] - tb[31 * 12 + h]) * (1.0f / att::SCALE); }
        }
    }
    SEAM(0);
    for (int rep_ = IN(1) ? 1 + (int)(((REPMASK) >> 1) & 1u) : 0; rep_ > 0; --rep_) { RETID();
        const bool split = F.G >= 256; const int XG = split ? P1_GEMM_CUS : F.G;
        if ((int)blockIdx.x < XG) {
            { pg8::Gemm g{H, WIN, DM, 0, 0}; pg8::PanelOrder<0> S; S.init(T, XG, (int)blockIdx.x, split ? 4 : 8);
              pg8::EpiQKV E{QKV, LDQKV, KMEAN, 1.0f};
              pg8::gemm_phase<pg8::EpiQKV, pg8::PanelOrder<0>, true, false>(F.lds + RING_OFF, g, S, E, F.tid); }
            VM_WAIT(); __syncthreads();
            if (split) {
                if (F.tid == 0) { XB_SPIN(xb_ld(F.ctl + CW_GATE) < (unsigned)(F.G - XG), F.ctl + CW_BAR); __builtin_amdgcn_fence(__ATOMIC_ACQUIRE, "agent"); asm volatile("s_waitcnt vmcnt(0)" ::: "memory"); }
                __syncthreads();
            }
            { pg8::Gemm g{(const bf16*)H8, (const bf16*)W8, DM, LD8, LD8}; pg8::PanelOrder<1> S; S.init(T, XG, XG - 1 - (int)blockIdx.x, split ? 4 : 8);
              pg8::EpiQKV E{QKV, LDQKV, KMEAN, 1.0f / 64.0f};
              pg8::gemm_phase<pg8::EpiQKV, pg8::PanelOrder<1>, true, false, true>(F.lds + RING_OFF, g, S, E, F.tid); }
        }
        if (!split || (int)blockIdx.x >= XG) {
            const int c0 = split ? (int)blockIdx.x - XG : (int)blockIdx.x, nc = split ? F.G - XG : F.G;
            if (split) {
                tr_run<true>(TI_TOTAL + TI_W8E + c0 * NWAVES + F.wave, nc * NWAVES, TI_TOTAL + TI_W8, ws, F.lds + RING_OFF + F.wave * TR_LDS_PER_WAVE, F.lane);
                VM_WAIT(); __syncthreads();
                if (F.tid == 0) { __builtin_amdgcn_fence(__ATOMIC_RELEASE, "agent"); asm volatile("s_waitcnt vmcnt(0)" ::: "memory"); (void)xb_add(F.ctl + CW_GATE, 1u); }
            }
            tr_run<true>(TI_IN + c0 * NWAVES + F.wave, nc * NWAVES, split ? TI_S0 : TI_TOTAL, ws, F.lds + RING_OFF + F.wave * TR_LDS_PER_WAVE, F.lane);
        }
    }
    SEAM(1);
    for (int rep_ = IN(3) ? 1 + (int)(((REPMASK) >> 3) & 1u) : 0; rep_ > 0; --rep_) { RETID();
        LAS float* km = (LAS float*)(F.lds + RING_OFF);
        for (int it = F.vcu; it < NBATCH * 8 * 16; it += F.G) {
            const int b = it >> 7, h = (it >> 4) & 7, blk = it & 15;
            for (int i = F.tid; i < 16 * 128; i += NWAVES * 64) km[i] = KMEAN[(size_t)(b * 8 + h) * 2048 + i];
            __syncthreads();
            const int row = F.tid >> 1, half = F.tid & 1;
            const bf16* qp = QKV + ((size_t)b * SEQ + blk * 256 + row) * LDQKV + C_QA + h * 128 + half * 64;
            float q[64];
#pragma unroll
            for (int c = 0; c < 8; ++c) { const v4u w = *(const v4u*)(qp + 8 * c); q[8 * c] = bflo(w.x); q[8 * c + 1] = bfhi(w.x); q[8 * c + 2] = bflo(w.y); q[8 * c + 3] = bfhi(w.y);
                q[8 * c + 4] = bflo(w.z); q[8 * c + 5] = bfhi(w.z); q[8 * c + 6] = bflo(w.w); q[8 * c + 7] = bfhi(w.w); }
            float gate[16];
#pragma unroll
            for (int n = 0; n < 16; ++n) { float s = 0.f;
                if (n < blk) {
#pragma unroll
                    for (int d = 0; d < 64; d += 4) { const f32x4 kv = *(const LAS f32x4*)(km + n * 128 + half * 64 + d); s += q[d] * kv.x + q[d + 1] * kv.y + q[d + 2] * kv.z + q[d + 3] * kv.w; } }
                s += __shfl_xor(s, 1); gate[n] = s; }
            unsigned sel = 0u;
#pragma unroll
            for (int k = 0; k < 3; ++k) { float best = -__builtin_inff(); int bi = -1;
#pragma unroll
                for (int n = 0; n < 16; ++n) { const bool ok = (n < blk) && !((sel >> n) & 1u) && (bi < 0 || gate[n] > best); if (ok) { best = gate[n]; bi = n; } }
                if (bi >= 0) sel |= 1u << bi; }
            if (half == 0) SEL[(size_t)(b * 8 + h) * SEQ + blk * 256 + row] = (unsigned short)sel;
            __syncthreads();
        }
    }
    SEAM(3);
    for (int rep_ = IN(4) ? 1 + (int)(((REPMASK) >> 4) & 1u) : 0; rep_ > 0; --rep_) { RETID();
        constexpr int NIT = 768;
        const bool split4 = F.G >= 256; const int AG = split4 ? P4_ATT_CUS : F.G;
        const int bx4 = (int)blockIdx.x, av = split4 ? (bx4 % 8) * (AG / 8) + bx4 / 8 : F.vcu;
#define ITEM4(rnd_) (split4 ? ((rnd_) < 4 && ATT_LPT[av * 4 + ((rnd_) & 3)] >= 0 ? (int)ATT_LPT[av * 4 + ((rnd_) & 3)] : NIT) : (((rnd_) & 1) ? (rnd_) * AG + (AG - 1 - av) : (rnd_) * AG + av))
        int rnd = 0; int idx = ITEM4(0);
        if (split4 && bx4 >= AG) {
            tr_run<true>(TI_S0 + (bx4 - AG) * NWAVES + F.wave, (F.G - AG) * NWAVES, TI_TOTAL - TI_DEFER - TI_P10, ws, F.lds + RING_OFF + F.wave * TR_LDS_PER_WAVE, F.lane);
        } else if (idx < NIT) {
            att::BlockRef cur = mk_self_ref(idx, QKV, OM, ODP, LUT, SEL); att::Seam S;
            att::attn_prime(cur, F.ldsg + RING_OFF, S, F.tid);
            for (;;) {
                const int nidx = ITEM4(rnd + 1); const bool last = nidx >= NIT;
                att::BlockRef nxt = cur;
                att::attn_block<true>(cur, last ? -1 : nidx, [&](int i_) { nxt = mk_self_ref(i_, QKV, OM, ODP, LUT, SEL); return nxt; }, F.ldsg + RING_OFF, S, F.tid);
                if (last) break;
                cur = nxt; ++rnd;
            }
        }
        VM_WAIT(); __syncthreads();
    }
    SEAM(4);
    for (int rep_ = IN(5) ? 1 + (int)(((REPMASK) >> 5) & 1u) : 0; rep_ > 0; --rep_) { RETID();
        float lam;
        { const float a = AIN(5)[F.lane] * AIN(6)[F.lane] + AIN(5)[F.lane + 64] * AIN(6)[F.lane + 64];
          const float c = AIN(7)[F.lane] * AIN(8)[F.lane] + AIN(7)[F.lane + 64] * AIN(8)[F.lane + 64];
          lam = expf(wave_sum(a)) - expf(wave_sum(c)) + 0.2f; }
        const int hl = F.lane >> 5, j = F.lane & 31;
        const f32x4 g0 = *(const f32x4*)(AIN(9) + 8 * j), g1 = *(const f32x4*)(AIN(9) + 8 * j + 4);
        for (int it = gw; it < T * 2; it += NGW) {
            const int t = it >> 1, h = (it & 1) * 2 + hl;
            const bf16* p0 = ODP + (size_t)t * 2048 + (h * 2) * 256 + 8 * j; const bf16* p1 = p0 + 256;
            const v4u a = *(const v4u*)p0, c = *(const v4u*)p1;
            float o[8];
            o[0] = bflo(a.x) - lam * bflo(c.x); o[1] = bfhi(a.x) - lam * bfhi(c.x); o[2] = bflo(a.y) - lam * bflo(c.y); o[3] = bfhi(a.y) - lam * bfhi(c.y);
            o[4] = bflo(a.z) - lam * bflo(c.z); o[5] = bfhi(a.z) - lam * bfhi(c.z); o[6] = bflo(a.w) - lam * bflo(c.w); o[7] = bfhi(a.w) - lam * bfhi(c.w);
            float s2 = 0.f;
#pragma unroll
            for (int k = 0; k < 8; ++k) s2 += o[k] * o[k];
#pragma unroll
            for (int m = 1; m < 32; m <<= 1) s2 += __shfl_xor(s2, m);
            const float rs = 0.8f / sqrtf(s2 * (1.0f / 256.0f) + NORM_EPS);
            v4u w; w.x = pk2(o[0] * rs * g0.x, o[1] * rs * g0.y); w.y = pk2(o[2] * rs * g0.z, o[3] * rs * g0.w); w.z = pk2(o[4] * rs * g1.x, o[5] * rs * g1.y); w.w = pk2(o[6] * rs * g1.z, o[7] * rs * g1.w);
            *(v4u*)(ODN + (size_t)t * 1024 + h * 256 + 8 * j) = w;
        }
    }
    SEAM(5);
    for (int rep_ = IN(6) ? 1 + (int)(((REPMASK) >> 6) & 1u) : 0; rep_ > 0; --rep_) { RETID();
        { pg8::Gemm g{OM, WBM, 1024, OMP, OMP}; pg8::StaticOrder S; S.init(T, DM, F.G, (int)blockIdx.x);
          pg8::EpiGate<false> E{QKV + C_GA, LDQKV, nullptr, T1, DM, 1.0f / 1024.0f};
          pg8::gemm_phase<pg8::EpiGate<false>, pg8::StaticOrder, true, false, true>(F.lds + RING_OFF, g, S, E, F.tid); }
        VM_WAIT(); __syncthreads();
        { pg8::Gemm g{ODN, WBD, 1024, 0, 0}; pg8::StaticOrder S; S.init(T, DM, F.G, (int)blockIdx.x);
          pg8::EpiGate<true> E{QKV + C_GB, LDQKV, T1, MRG, DM, 1.0f};
          pg8::gemm_phase<pg8::EpiGate<true>, pg8::StaticOrder, true, false>(F.lds + RING_OFF, g, S, E, F.tid); }
    }
    SEAM(6);
    for (int rep_ = IN(7) ? 1 + (int)(((REPMASK) >> 7) & 1u) : 0; rep_ > 0; --rep_) { RETID();
        pg8::Gemm g{MRG, WMIX, DM, 0, 0}; pg8::StaticOrder S; S.init(T, DM, F.G, (int)blockIdx.x);
        pg8::EpiResF32X E{AIN(0), nullptr, DM, HX, SSQ, HX8, AIN(13), LD8};
        pg8::gemm_phase<pg8::EpiResF32X, pg8::StaticOrder, true, false>(F.lds + RING_OFF, g, S, E, F.tid);
    }
    SEAM(7);
    for (int rep_ = IN(9) ? 1 + (int)(((REPMASK) >> 9) & 1u) : 0; rep_ > 0; --rep_) { RETID();
        { pg8::Gemm g{(const bf16*)HX8, (const bf16*)WXQ, DM, LD8, LD8}; pg8::StaticOrder S; S.init(T, 512, F.G, (int)blockIdx.x);
          pg8::EpiXQ E{QX, 512, SSQ, NORM_EPS, 1.0f / 64.0f};
          pg8::gemm_phase<pg8::EpiXQ, pg8::StaticOrder, true, false, true>(F.lds + RING_OFF, g, S, E, F.tid); }
        VM_WAIT(); __syncthreads();
        { const int c2 = (int)blockIdx.x - 64; pg8::Gemm g{(const bf16*)MEMN8, (const bf16*)WXKV, DM, LD8, LD8}; pg8::StaticOrder S; S.init(NBATCH * MEMLEN, 1024, F.G, (c2 >= 0 && c2 < 8) ? c2 : -1);
          pg8::EpiBf16 E{KVX, 1024, 1.0f / 64.0f};
          pg8::gemm_phase<pg8::EpiBf16, pg8::StaticOrder, true, false, true>(F.lds + RING_OFF, g, S, E, F.tid); }
        if (F.G >= 256 && (int)blockIdx.x >= 72) {
            tr_run<true>(TI_TOTAL - TI_DEFER + ((int)blockIdx.x - 72) * NWAVES + F.wave, (F.G - 72) * NWAVES, TI_TOTAL, ws, F.lds + RING_OFF + F.wave * TR_LDS_PER_WAVE, F.lane);
        }
    }
    SEAM(9);
    for (int rep_ = IN(10) ? 1 + (int)(((REPMASK) >> 10) & 1u) : 0; rep_ > 0; --rep_) { RETID();
        int idx = F.vcu;
        if (idx < 128) {
            att::BlockRef cur = mk_cross_ref(idx, QX, KVX, OX); att::Seam S;
            att::attn_prime(cur, F.ldsg + RING_OFF, S, F.tid);
            for (;;) {
                const int nidx = idx + F.G; const bool last = nidx >= 128;
                att::BlockRef nxt = cur;
                att::attn_block<false>(cur, last ? -1 : nidx, [&](int i_) { nxt = mk_cross_ref(i_, QX, KVX, OX); return nxt; }, F.ldsg + RING_OFF, S, F.tid);
                if (last) break;
                cur = nxt; idx = nidx;
            }
        } else if (F.G >= 256) {
            tr_run<true>(TI_TOTAL - TI_DEFER - TI_P10 + (idx - 128) * NWAVES + F.wave, (F.G - 128) * NWAVES, TI_TOTAL - TI_DEFER, ws, F.lds + RING_OFF + F.wave * TR_LDS_PER_WAVE, F.lane);
        }
        VM_WAIT(); __syncthreads();
    }
    SEAM(10);
    for (int rep_ = IN(11) ? 1 + (int)(((REPMASK) >> 11) & 1u) : 0; rep_ > 0; --rep_) { RETID();
        pg8::Gemm g{OX, WXO, 512, 0, 0}; pg8::StaticOrder S; S.init(T, DM, F.G, (int)blockIdx.x);
        pg8::EpiResBfBf E{HX, X2, DM};
        pg8::gemm_phase<pg8::EpiResBfBf, pg8::StaticOrder, true, false>(F.lds + RING_OFF, g, S, E, F.tid);
    }
    SEAM(11);
    for (int rep_ = IN(12) ? 1 + (int)(((REPMASK) >> 12) & 1u) : 0; rep_ > 0; --rep_) { RETID();
        constexpr int HP = 4112;
        LAS unsigned char* hsH = F.lds + RING_OFF;
        LAS unsigned char* hsL = F.lds + RING_OFF + 16 * HP;
        LAS float* part = (LAS float*)(F.lds + RING_OFF);
        LAS float* lg = (LAS float*)(F.lds + RING_OFF + 2 * 16 * HP);
        const float* br = AIN(21);
        typedef short bf16x8_t __attribute__((ext_vector_type(8)));
        LAS int* pkE = (LAS int*)(F.lds + TAB_OFF);
        LAS int* pkM = (LAS int*)(F.lds + TAB_OFF) + 128;
        LAS float* pkW = (LAS float*)(F.lds + RING_OFF + 2 * 16 * HP + 2048);
        LAS int* pkB = (LAS int*)(F.lds + RING_OFF + 2 * 16 * HP + 2048 + 512);
        int npick = 0;
        for (int base = F.vcu * 16; base < T; base += F.G * 16) {
            for (int rr = F.wave; rr < 16; rr += NWAVES) {
                const int m = base + rr;
                const GAS v2u* xr = (const GAS v2u*)(X2 + (size_t)m * DM) + F.lane; const GAS f32x4* gr = (const GAS f32x4*)AIN(19) + F.lane;
                f32x4 v[8]; float s2 = 0.f;
#pragma unroll
                for (int j = 0; j < 8; ++j) { const v2u w = xr[64 * j]; v[j].x = bflo(w.x); v[j].y = bfhi(w.x); v[j].z = bflo(w.y); v[j].w = bfhi(w.y);
                    s2 += (v[j].x * v[j].x + v[j].y * v[j].y) + (v[j].z * v[j].z + v[j].w * v[j].w); }
                const float rstd = 1.f / sqrtf(wave_sum(s2) * (1.f / DM) + NORM_EPS);
                GAS unsigned* o4 = (GAS unsigned*)((unsigned char*)HF + (size_t)m * LD8) + F.lane;
#pragma unroll
                for (int j = 0; j < 8; ++j) { const f32x4 gv = gr[64 * j]; float hn[4] = {v[j].x * rstd * gv.x, v[j].y * rstd * gv.y, v[j].z * rstd * gv.z, v[j].w * rstd * gv.w};
                    unsigned hi[4], lo[4];
#pragma unroll
                    for (int c = 0; c < 4; ++c) { hi[c] = f2bf(hn[c]); lo[c] = f2bf(hn[c] - __builtin_bit_cast(float, hi[c] << 16)); }
                    const v2u wh = {hi[0] | (hi[1] << 16), hi[2] | (hi[3] << 16)}, wl = {lo[0] | (lo[1] << 16), lo[2] | (lo[3] << 16)};
                    o4[64 * j] = pg8::pk4_fp8(hn[0], hn[1], hn[2], hn[3]);
                    *(LAS v2u*)(hsH + rr * HP + 8 * (F.lane + 64 * j)) = wh; *(LAS v2u*)(hsL + rr * HP + 8 * (F.lane + 64 * j)) = wl; }
            }
            __syncthreads();
            {
                const int fr = F.lane & 15, fq = F.lane >> 4;
                pg8::f32x4 acc0 = {0.f, 0.f, 0.f, 0.f}, acc1 = {0.f, 0.f, 0.f, 0.f};
#pragma unroll 2
                for (int ks = 0; ks < 8; ++ks) { const int k0 = F.wave * 256 + ks * 32 + fq * 8;
                    const bf16x8_t ah = *(const LAS bf16x8_t*)(hsH + fr * HP + k0 * 2), al = *(const LAS bf16x8_t*)(hsL + fr * HP + k0 * 2);
                    const bf16x8_t bh0 = *(const bf16x8_t*)(WRH + (size_t)fr * 2048 + k0), bl0 = *(const bf16x8_t*)(WRL + (size_t)fr * 2048 + k0);
                    const bf16x8_t bh1 = *(const bf16x8_t*)(WRH + (size_t)(16 + fr) * 2048 + k0), bl1 = *(const bf16x8_t*)(WRL + (size_t)(16 + fr) * 2048 + k0);
                    acc0 = __builtin_amdgcn_mfma_f32_16x16x32_bf16(ah, bh0, acc0, 0, 0, 0); acc0 = __builtin_amdgcn_mfma_f32_16x16x32_bf16(ah, bl0, acc0, 0, 0, 0); acc0 = __builtin_amdgcn_mfma_f32_16x16x32_bf16(al, bh0, acc0, 0, 0, 0);
                    acc1 = __builtin_amdgcn_mfma_f32_16x16x32_bf16(ah, bh1, acc1, 0, 0, 0); acc1 = __builtin_amdgcn_mfma_f32_16x16x32_bf16(ah, bl1, acc1, 0, 0, 0); acc1 = __builtin_amdgcn_mfma_f32_16x16x32_bf16(al, bh1, acc1, 0, 0, 0); }
                __syncthreads();
#pragma unroll
                for (int r = 0; r < 4; ++r) { part[(F.wave * 16 + 4 * fq + r) * 32 + fr] = acc0[r]; part[(F.wave * 16 + 4 * fq + r) * 32 + 16 + fr] = acc1[r]; }
            }
            __syncthreads();
            { const int r = F.tid >> 5, e = F.tid & 31; float s = br[e];
#pragma unroll
              for (int w = 0; w < 8; ++w) s += part[(w * 16 + r) * 32 + e];
              lg[r * 32 + e] = s; }
            __syncthreads();
            if (F.tid < 16) { const int m = base + F.tid; float l[32];
#pragma unroll
                for (int e = 0; e < 32; ++e) l[e] = lg[F.tid * 32 + e];
                int se[4]; float sv[4]; unsigned used = 0u;
#pragma unroll
                for (int k = 0; k < 4; ++k) { float best = -__builtin_inff(); int bi = 0;
#pragma unroll
                    for (int e = 0; e < 32; ++e) { const bool ok = !((used >> e) & 1u) && l[e] > best; if (ok) { best = l[e]; bi = e; } }
                    used |= 1u << bi; se[k] = bi; sv[k] = best; }
                float den = 0.f, ex[4];
#pragma unroll
                for (int k = 0; k < 4; ++k) { ex[k] = expf(sv[k] - sv[0]); den += ex[k]; }
#pragma unroll
                for (int k = 0; k < 4; ++k) { const int j = npick + F.tid * 4 + k; pkE[j] = se[k]; pkM[j] = m; pkW[j] = ex[k] / den; }
            }
            npick += 64;
            __syncthreads();
            if (npick == 128 || base + F.G * 16 >= T) {
                if (F.tid < 32) { int n = 0; for (int j = 0; j < npick; ++j) n += (pkE[j] == F.tid) ? 1 : 0;
                    pkB[F.tid] = n ? (int)__hip_atomic_fetch_add(F.ctl + CW_CNT + 64 * F.tid, (unsigned)n, RLX_AGENT) : 0; }
                __syncthreads();
                if (F.tid < npick) { const int j = F.tid, e = pkE[j]; int rank = 0; for (int i = 0; i < j; ++i) rank += (pkE[i] == e) ? 1 : 0;
                    const int pos = pkB[e] + rank, m = pkM[j];
                    TOK[(size_t)e * CAP + pos] = m; CWT[(size_t)e * CAP + pos] = pkW[j]; TSEL[(size_t)m * 4 + (j & 3)] = (e << 16) | pos; }
                npick = 0;
                __syncthreads();
            }
        }
    }
    SEAM(12);
    for (int rep_ = IN(13) ? 1 + (int)(((REPMASK) >> 13) & 1u) : 0; rep_ > 0; --rep_) { RETID();
        moe_tables(F);
        pg8::Gemm g{HF, WGU, DM, LD8, LD8}; pg8::MoeOrder S; S.init((const LAS int*)(F.lds + TAB_OFF), TOK, 16, F.G, (int)blockIdx.x, CAP);
        pg8::EpiGU E{AIN(23), (unsigned char*)ACT, LD8};
        pg8::gemm_phase<pg8::EpiGU, pg8::MoeOrder, true, true, true>(F.lds + RING_OFF, g, S, E, F.tid);
        VM_WAIT(); __syncthreads();
        { pg8::MoeTail S2; S2.init((const LAS int*)(F.lds + TAB_OFF), TOK, 16, F.G, (int)blockIdx.x, CAP);
          pg8::gemm_phase<pg8::EpiGU, pg8::MoeTail, true, true, true>(F.lds + RING_OFF, g, S2, E, F.tid); }
    }
    SEAM(13);
    for (int rep_ = IN(14) ? 1 + (int)(((REPMASK) >> 14) & 1u) : 0; rep_ > 0; --rep_) { RETID();
        moe_tables(F);
        pg8::Gemm g{ACT, WDN, DM, LD8, LD8}; pg8::MoeOrder S; S.init((const LAS int*)(F.lds + TAB_OFF), TOK, 8, F.G, (int)blockIdx.x, CAP);
        pg8::EpiDown E{AIN(25), CWT, CAP, YB};
        pg8::gemm_phase<pg8::EpiDown, pg8::MoeOrder, true, false, true>(F.lds + RING_OFF, g, S, E, F.tid);
        VM_WAIT(); __syncthreads();
        { pg8::MoeTail S2; S2.init((const LAS int*)(F.lds + TAB_OFF), TOK, 8, F.G, (int)blockIdx.x, CAP);
          pg8::gemm_phase<pg8::EpiDown, pg8::MoeTail, true, false, true>(F.lds + RING_OFF, g, S2, E, F.tid); }
    }
    SEAM(14);
    for (int rep_ = IN(15) ? 1 + (int)(((REPMASK) >> 15) & 1u) : 0; rep_ > 0; --rep_) { RETID();
        moe_tables(F);
        const LAS int* tab = (const LAS int*)(F.lds + TAB_OFF);
        const unsigned poison = xb_ld(F.ctl + CW_BAR + XB_TMO);
        for (int m = gw; m < T; m += NGW) {
            float v[4][8];
#pragma unroll
            for (int j = 0; j < 4; ++j) { const v4u w = *(const v4u*)(X2 + (size_t)m * DM + 8 * (F.lane + 64 * j));
                v[j][0] = bflo(w.x); v[j][1] = bfhi(w.x); v[j][2] = bflo(w.y); v[j][3] = bfhi(w.y); v[j][4] = bflo(w.z); v[j][5] = bfhi(w.z); v[j][6] = bflo(w.w); v[j][7] = bfhi(w.w); }
#pragma unroll
            for (int k = 0; k < 4; ++k) { const int ts = TSEL[(size_t)m * 4 + k]; const int e = ts >> 16, pos = ts & 0xffff; const size_t row = (size_t)tab[e] * 256 + pos;
#pragma unroll
                for (int j = 0; j < 4; ++j) { const v4u w = *(const v4u*)(YB + row * DM + 8 * (F.lane + 64 * j));
                    v[j][0] += bflo(w.x); v[j][1] += bfhi(w.x); v[j][2] += bflo(w.y); v[j][3] += bfhi(w.y); v[j][4] += bflo(w.z); v[j][5] += bfhi(w.z); v[j][6] += bflo(w.w); v[j][7] += bfhi(w.w); } }
            float s2 = 0.f;
#pragma unroll
            for (int j = 0; j < 4; ++j)
#pragma unroll
                for (int k = 0; k < 8; ++k) s2 += v[j][k] * v[j][k];
            float rstd = 1.f / sqrtf(wave_sum(s2) * (1.f / DM) + NORM_EPS);
            if (poison) rstd = __builtin_nanf("");
#pragma unroll
            for (int j = 0; j < 4; ++j) { const float* gp = AIN(26) + 8 * (F.lane + 64 * j); const f32x4 ga = *(const f32x4*)gp, gb = *(const f32x4*)(gp + 4);
                f32x4 oa, ob; oa.x = v[j][0] * rstd * ga.x; oa.y = v[j][1] * rstd * ga.y; oa.z = v[j][2] * rstd * ga.z; oa.w = v[j][3] * rstd * ga.w;
                ob.x = v[j][4] * rstd * gb.x; ob.y = v[j][5] * rstd * gb.y; ob.z = v[j][6] * rstd * gb.z; ob.w = v[j][7] * rstd * gb.w;
                *(f32x4*)((kargs()->out) + (size_t)m * DM + 8 * (F.lane + 64 * j)) = oa; *(f32x4*)((kargs()->out) + (size_t)m * DM + 8 * (F.lane + 64 * j) + 4) = ob; }
        }
    }
#undef IN
#undef SEAM
}

extern "C" void kernel_launch(void* const* d_in, const int* in_sizes, int n_in, void* d_out, int out_size, void* d_ws, size_t ws_size, hipStream_t stream) {
    static int grid = 0;
    if (grid == 0) {
        if (n_in != 27 || out_size != T * DM || ws_size < WS_END) { fprintf(stderr, "kernel_launch: unexpected shapes (n_in %d out %d ws %zu)\n", n_in, out_size, ws_size); grid = -1; return; }
        int dev = 0, cus = 0, per_cu = 0;
        if (hipGetDevice(&dev) != hipSuccess || hipDeviceGetAttribute(&cus, hipDeviceAttributeMultiprocessorCount, dev) != hipSuccess) { grid = -1; return; }
        if (hipFuncSetAttribute((const void*)fwd, hipFuncAttributeMaxDynamicSharedMemorySize, LDS_BYTES) != hipSuccess) { fprintf(stderr, "kernel_launch: hipFuncSetAttribute failed\n"); grid = -1; return; }
        if (hipOccupancyMaxActiveBlocksPerMultiprocessor(&per_cu, (const void*)fwd, NWAVES * 64, LDS_BYTES) != hipSuccess || per_cu < 1) fprintf(stderr, "kernel_launch: occupancy query reports %d\n", per_cu);
        (void)hipGetLastError();
        grid = cus;
    }
    if (grid < 0) return;
    if (hipMemsetAsync((char*)d_ws + WS_CTL, 0, CTL_ZERO_BYTES, stream) != hipSuccess) return;
    Args a{};
    for (int i = 0; i < 27; ++i) a.in[i] = (const float*)d_in[i];
    a.out = (float*)d_out; a.ws = (unsigned char*)d_ws;
#if MK_ONE_LAUNCH
    a.ph_lo = 0; a.ph_hi = N_PHASES + 1;
    hipLaunchKernelGGL(fwd, dim3(grid), dim3(NWAVES * 64), LDS_BYTES, stream, a);
#else
    for (int p = 0; p <= N_PHASES; ++p) { a.ph_lo = p; a.ph_hi = p + 1; hipLaunchKernelGGL(fwd, dim3(grid), dim3(NWAVES * 64), LDS_BYTES, stream, a); }
#endif
}
```

```cpp
#include <hip/hip_runtime.h>
#include <cstdio>
#include <cstdint>
#include <cmath>
namespace pg8 {
#define PG8_LAS __attribute__((address_space(3)))
typedef unsigned short bf16_t;
typedef short bf16x8 __attribute__((ext_vector_type(8)));
typedef float f32x4 __attribute__((ext_vector_type(4)));
typedef float f32x2 __attribute__((ext_vector_type(2)));
typedef unsigned u32x4 __attribute__((ext_vector_type(4)));
typedef unsigned u32x2 __attribute__((ext_vector_type(2)));
typedef long i64x2 __attribute__((ext_vector_type(2)));
typedef int i32x4 __attribute__((ext_vector_type(4)));
typedef int i32x8 __attribute__((ext_vector_type(8)));
constexpr int BM = 256, BK = 64, HALF = 128, HTB = HALF * BK * 2  , STAGE_BYTES = 8 * HTB, NXCD = 8, WGM = 8;

__host__ __device__ __forceinline__ int lds_byte(int r, int c) { const int st = (r >> 4) * 2 + (c >> 5), rr = r & 15, cc = c & 31, ob = rr * 64 + cc * 2; return st * 1024 + (ob ^ (((ob >> 9) & 1) << 5)); }
__host__ __device__ __forceinline__ void stage_rc(int b, int& R, int& C) { const int st = b / 1024, sb = b % 1024, swz = sb ^ (((sb >> 9) & 1) << 5); R = (st >> 1) * 16 + swz / 64; C = (st & 1) * 32 + (swz % 64) / 2; }
__host__ __device__ __forceinline__ int perm32(int rho) { const int n = rho >> 4, i = rho & 15; return 8 * (i >> 2) + 4 * n + (i & 3); }

struct Unit { int pm, pn, pb, e, lrow0, cnt, bjm; };
struct Gemm { const bf16_t* A; const bf16_t* Bt; int K; int lda, ldb; };

struct StaticOrder {
    int nM, nN, nwg, G, c, wgm;
    __device__ void init(int M, int N, int G_, int c_, int wgm_ = WGM) { nM = M / BM; nN = N / BM; nwg = nM * nN; G = G_; c = c_; wgm = wgm_; }
    __device__ bool next(int i, Unit& u) const {
        if (c < 0) return false;
        const long L = (long)i * G + c; if (L >= nwg) return false;
        int wgid = (int)L; { const int q = nwg / NXCD, r = nwg % NXCD, xcd = wgid % NXCD, off = wgid / NXCD; wgid = (xcd < r ? xcd * (q + 1) : r * (q + 1) + (xcd - r) * q) + off; }
        const int nig = wgm * nN, gid = wgid / nig, fm = gid * wgm, gsz = (nM - fm) < wgm ? (nM - fm) : wgm;
        u.pm = fm + ((wgid % nig) % gsz); u.pn = (wgid % nig) / gsz; u.pb = u.pn; u.e = 0; u.lrow0 = 0; u.cnt = 0; u.bjm = 3; return true;
    }
    __device__ __forceinline__ int arow(const Unit&, int) const { return 0; }
};

template <int KIND> struct PanelOrder {
    StaticOrder S;
    __device__ void init(int M, int G_, int c_, int wgm_) { S.init(M, (KIND ? 28 : 12) * BM, G_, c_, wgm_); }
    __device__ bool next(int i, Unit& u) const {
        if (!S.next(i, u)) return false;
        const int j = u.pn;
        if (KIND == 0) { u.pn = 12 + j; u.pb = u.pn; }
        else { u.pb = j; u.pn = j < 12 ? j : 12 + j; }
        return true;
    }
    __device__ __forceinline__ int arow(const Unit&, int) const { return 0; }
};
__device__ __forceinline__ void moe_decode(const PG8_LAS int* tab, int nN, int nwg, long L, int bjm, Unit& u) {
    int wgid = (int)L; { const int q = nwg / NXCD, r = nwg % NXCD, xcd = wgid % NXCD, off = wgid / NXCD; wgid = (xcd < r ? xcd * (q + 1) : r * (q + 1) + (xcd - r) * q) + off; }
    int e = 0;
    for (int j = 1; j < 32; ++j) if (tab[j] * nN <= wgid) e = j;
    const int t0 = tab[e], te = tab[e + 1] - t0, r = wgid - t0 * nN;
    const int pn = r / te, pl = r - pn * te;
    u.pm = t0 + pl; u.pn = pn; u.pb = e * nN + pn; u.e = e; u.lrow0 = pl * BM; u.cnt = tab[64 + e]; u.bjm = bjm;
}
__device__ __forceinline__ bool moe_split(int nwg, int G, int& R, int& rem) { R = nwg / G; rem = nwg - R * G; return rem > 0 && 2 * rem <= G && (G % NXCD) == 0; }
struct MoeOrder {
    const PG8_LAS int* tab; const int* tok; int nN, nwg, G, c, cap;
    __device__ void init(const PG8_LAS int* tab_, const int* tok_, int nN_, int G_, int c_, int cap_) { tab = tab_; tok = tok_; nN = nN_; G = G_; c = c_; cap = cap_; nwg = tab_[32] * nN_; }
    __device__ bool next(int i, Unit& u) const {
        int R, rem; const bool split = moe_split(nwg, G, R, rem);
        const long L = (long)i * G + c; if (L >= (split ? (long)R * G : (long)nwg)) return false;
        moe_decode(tab, nN, nwg, L, 3, u); return true;
    }
    __device__ __forceinline__ int arow(const Unit& u, int r) const { const int lr = u.lrow0 + r; return lr < u.cnt ? tok[(size_t)u.e * cap + lr] : 0; }
};
struct MoeTail {
    static constexpr bool ROWSKIP = true;
    const PG8_LAS int* tab; const int* tok; int nN, nwg, G, c, cap;
    __device__ void init(const PG8_LAS int* tab_, const int* tok_, int nN_, int G_, int c_, int cap_) { tab = tab_; tok = tok_; nN = nN_; G = G_; c = c_; cap = cap_; nwg = tab_[32] * nN_; }
    __device__ bool next(int i, Unit& u) const {
        int R, rem; if (i != 0 || !moe_split(nwg, G, R, rem)) return false;
        const int x = c % NXCD, sidx = c / NXCD, m = x + NXCD * (sidx >> 1);
        if (m >= rem) return false;
        moe_decode(tab, nN, nwg, (long)R * G + m, 1 << (sidx & 1), u); return true;
    }
    __device__ __forceinline__ int arow(const Unit& u, int r) const { const int lr = u.lrow0 + r; return lr < u.cnt ? tok[(size_t)u.e * cap + lr] : 0; }
};
template <class S, class = void> struct sched_rowskip { static constexpr bool value = false; };
template <class S> struct sched_rowskip<S, decltype((void)S::ROWSKIP)> { static constexpr bool value = true; };

__device__ __forceinline__ unsigned cvt_pk_bf16(float lo, float hi) { unsigned r; asm volatile("v_cvt_pk_bf16_f32 %0, %1, %2" : "=v"(r) : "v"(lo), "v"(hi)); return r; }
__device__ __forceinline__ unsigned pk4_fp8(float a, float b, float c, float d);
__device__ __forceinline__ float bf_lo(unsigned w) { return __builtin_bit_cast(float, w << 16); }
__device__ __forceinline__ float bf_hi(unsigned w) { return __builtin_bit_cast(float, w & 0xffff0000u); }
__device__ __forceinline__ float sigmoidf_(float x) { return __builtin_amdgcn_rcpf(1.0f + __builtin_amdgcn_exp2f(-1.4426950408889634f * x)); }

struct EpiBf16 {
    static constexpr bool PERM = true;
    bf16_t* O; int ldc; float scale;
    __device__ __forceinline__ void operator()(const f32x4 (&acc)[2][2][4][2], const Unit& u, int wr, int wc, int fr, int fq) const {
        const int row0 = u.pm * BM + wr * 64 + fr, col0 = u.pn * BM + wc * 32 + 8 * fq;
#pragma unroll
        for (int ai = 0; ai < 2; ++ai)
#pragma unroll
            for (int m = 0; m < 4; ++m) { bf16_t* rowp = O + (size_t)(row0 + ai * HALF + m * 16) * ldc + col0;
#pragma unroll
                for (int bj = 0; bj < 2; ++bj) { const f32x4 v0 = acc[ai][bj][m][0] * scale, v1 = acc[ai][bj][m][1] * scale;
                    u32x4 w; w.x = cvt_pk_bf16(v0[0], v0[1]); w.y = cvt_pk_bf16(v0[2], v0[3]); w.z = cvt_pk_bf16(v1[0], v1[1]); w.w = cvt_pk_bf16(v1[2], v1[3]);
                    *(u32x4*)(rowp + bj * HALF) = w; } }
    }
};
template <bool ADD> struct EpiGate {
    static constexpr bool PERM = true;
    const bf16_t* G; int ldg; const bf16_t* T; bf16_t* O; int ldc; float scale;
    __device__ __forceinline__ void operator()(const f32x4 (&acc)[2][2][4][2], const Unit& u, int wr, int wc, int fr, int fq) const {
        const int row0 = u.pm * BM + wr * 64 + fr, col0 = u.pn * BM + wc * 32 + 8 * fq;
#pragma unroll
        for (int ai = 0; ai < 2; ++ai) {
            u32x4 gv[4][2], tv[4][2];
#pragma unroll
            for (int m = 0; m < 4; ++m) { const size_t r = (size_t)(row0 + ai * HALF + m * 16);
#pragma unroll
                for (int bj = 0; bj < 2; ++bj) { gv[m][bj] = *(const u32x4*)(G + r * ldg + col0 + bj * HALF); if (ADD) tv[m][bj] = *(const u32x4*)(T + r * ldc + col0 + bj * HALF); } }
            asm volatile("" ::: "memory");
#pragma unroll
            for (int m = 0; m < 4; ++m) { const size_t r = (size_t)(row0 + ai * HALF + m * 16);
#pragma unroll
                for (int bj = 0; bj < 2; ++bj) { const f32x4 v0 = acc[ai][bj][m][0] * scale, v1 = acc[ai][bj][m][1] * scale;
                    const u32x4 g = gv[m][bj];
                    float o[8];
                    o[0] = v0[0] * sigmoidf_(bf_lo(g.x)); o[1] = v0[1] * sigmoidf_(bf_hi(g.x)); o[2] = v0[2] * sigmoidf_(bf_lo(g.y)); o[3] = v0[3] * sigmoidf_(bf_hi(g.y));
                    o[4] = v1[0] * sigmoidf_(bf_lo(g.z)); o[5] = v1[1] * sigmoidf_(bf_hi(g.z)); o[6] = v1[2] * sigmoidf_(bf_lo(g.w)); o[7] = v1[3] * sigmoidf_(bf_hi(g.w));
                    if (ADD) { const u32x4 t = tv[m][bj];
                        o[0] += bf_lo(t.x); o[1] += bf_hi(t.x); o[2] += bf_lo(t.y); o[3] += bf_hi(t.y); o[4] += bf_lo(t.z); o[5] += bf_hi(t.z); o[6] += bf_lo(t.w); o[7] += bf_hi(t.w); }
                    u32x4 w; w.x = cvt_pk_bf16(o[0], o[1]); w.y = cvt_pk_bf16(o[2], o[3]); w.z = cvt_pk_bf16(o[4], o[5]); w.w = cvt_pk_bf16(o[6], o[7]);
                    *(u32x4*)(O + r * ldc + col0 + bj * HALF) = w; } }
        }
    }
};
struct EpiResF32 {
    static constexpr bool PERM = false;
    const float* base; float* out; int ldc;
    __device__ __forceinline__ void operator()(const f32x4 (&acc)[2][2][4][2], const Unit& u, int wr, int wc, int fr, int fq) const {
        const int row0 = u.pm * BM + wr * 64 + fr, col0 = u.pn * BM + wc * 32 + 4 * fq;
#pragma unroll
        for (int ai = 0; ai < 2; ++ai) {
            f32x4 bs[4][2][2];
#pragma unroll
            for (int m = 0; m < 4; ++m) { const size_t off = (size_t)(row0 + ai * HALF + m * 16) * ldc + col0;
#pragma unroll
                for (int bj = 0; bj < 2; ++bj)
#pragma unroll
                    for (int n = 0; n < 2; ++n) bs[m][bj][n] = *(const f32x4*)(base + off + bj * HALF + n * 16); }
            asm volatile("" ::: "memory");
#pragma unroll
            for (int m = 0; m < 4; ++m) { const size_t off = (size_t)(row0 + ai * HALF + m * 16) * ldc + col0;
#pragma unroll
                for (int bj = 0; bj < 2; ++bj)
#pragma unroll
                    for (int n = 0; n < 2; ++n) *(f32x4*)(out + off + bj * HALF + n * 16) = bs[m][bj][n] + acc[ai][bj][m][n]; }
        }
    }
};
struct EpiResBf {
    static constexpr bool PERM = false;
    const bf16_t* base; float* out; int ldc;
    __device__ __forceinline__ void operator()(const f32x4 (&acc)[2][2][4][2], const Unit& u, int wr, int wc, int fr, int fq) const {
        const int row0 = u.pm * BM + wr * 64 + fr, col0 = u.pn * BM + wc * 32 + 4 * fq;
#pragma unroll
        for (int ai = 0; ai < 2; ++ai) {
            u32x2 bs[4][2][2];
#pragma unroll
            for (int m = 0; m < 4; ++m) { const size_t off = (size_t)(row0 + ai * HALF + m * 16) * ldc + col0;
#pragma unroll
                for (int bj = 0; bj < 2; ++bj)
#pragma unroll
                    for (int n = 0; n < 2; ++n) bs[m][bj][n] = *(const u32x2*)(base + off + bj * HALF + n * 16); }
            asm volatile("" ::: "memory");
#pragma unroll
            for (int m = 0; m < 4; ++m) { const size_t off = (size_t)(row0 + ai * HALF + m * 16) * ldc + col0;
#pragma unroll
                for (int bj = 0; bj < 2; ++bj)
#pragma unroll
                    for (int n = 0; n < 2; ++n) { const u32x2 w = bs[m][bj][n]; f32x4 r;
                        r[0] = __uint_as_float(w.x << 16); r[1] = __uint_as_float(w.x & 0xffff0000u); r[2] = __uint_as_float(w.y << 16); r[3] = __uint_as_float(w.y & 0xffff0000u);
                        *(f32x4*)(out + off + bj * HALF + n * 16) = r + acc[ai][bj][m][n]; } }
        }
    }
};
struct EpiResBfBf {
    static constexpr bool PERM = true;
    const bf16_t* base; bf16_t* out; int ldc; float scale;
    __device__ __forceinline__ void operator()(const f32x4 (&acc)[2][2][4][2], const Unit& u, int wr, int wc, int fr, int fq) const {
        const int row0 = u.pm * BM + wr * 64 + fr, col0 = u.pn * BM + wc * 32 + 8 * fq;
#pragma unroll
        for (int ai = 0; ai < 2; ++ai) {
            u32x4 tv[4][2];
#pragma unroll
            for (int m = 0; m < 4; ++m) { const size_t r = (size_t)(row0 + ai * HALF + m * 16);
#pragma unroll
                for (int bj = 0; bj < 2; ++bj) tv[m][bj] = *(const u32x4*)(base + r * ldc + col0 + bj * HALF); }
            asm volatile("" ::: "memory");
#pragma unroll
            for (int m = 0; m < 4; ++m) { const size_t r = (size_t)(row0 + ai * HALF + m * 16);
#pragma unroll
                for (int bj = 0; bj < 2; ++bj) { const f32x4 v0 = acc[ai][bj][m][0] * scale, v1 = acc[ai][bj][m][1] * scale; const u32x4 t = tv[m][bj];
                    u32x4 w; w.x = cvt_pk_bf16(v0[0] + bf_lo(t.x), v0[1] + bf_hi(t.x)); w.y = cvt_pk_bf16(v0[2] + bf_lo(t.y), v0[3] + bf_hi(t.y));
                    w.z = cvt_pk_bf16(v1[0] + bf_lo(t.z), v1[1] + bf_hi(t.z)); w.w = cvt_pk_bf16(v1[2] + bf_lo(t.w), v1[3] + bf_hi(t.w));
                    *(u32x4*)(out + r * ldc + col0 + bj * HALF) = w; } }
        }
    }
};
struct EpiQKV8 {
    static constexpr bool PERM = true;
    bf16_t* O; int ldc;
    __device__ __forceinline__ void operator()(const f32x4 (&acc)[2][2][4][2], const Unit& u, int wr, int wc, int fr, int fq) const {
        const int row0 = u.pm * BM + wr * 64 + fr, col0 = u.pn * BM + wc * 32 + 8 * fq;
        const float sc = 1.0f / 64.0f;
#pragma unroll
        for (int ai = 0; ai < 2; ++ai)
#pragma unroll
            for (int m = 0; m < 4; ++m) { bf16_t* rowp = O + (size_t)(row0 + ai * HALF + m * 16) * ldc + col0;
#pragma unroll
                for (int bj = 0; bj < 2; ++bj) { const f32x4 v0 = acc[ai][bj][m][0] * sc, v1 = acc[ai][bj][m][1] * sc;
                    u32x4 w; w.x = cvt_pk_bf16(v0[0], v0[1]); w.y = cvt_pk_bf16(v0[2], v0[3]); w.z = cvt_pk_bf16(v1[0], v1[1]); w.w = cvt_pk_bf16(v1[2], v1[3]);
                    *(u32x4*)(rowp + bj * HALF) = w; } }
    }
};
struct EpiQKV {
    static constexpr bool PERM = true;
    bf16_t* O; int ldc; float* kmean; float scale;
    __device__ __forceinline__ void operator()(const f32x4 (&acc)[2][2][4][2], const Unit& u, int wr, int wc, int fr, int fq) const {
        const int row0 = u.pm * BM + wr * 64 + fr, col0 = u.pn * BM + wc * 32 + 8 * fq;
#pragma unroll
        for (int ai = 0; ai < 2; ++ai)
#pragma unroll
            for (int m = 0; m < 4; ++m) { bf16_t* rowp = O + (size_t)(row0 + ai * HALF + m * 16) * ldc + col0;
#pragma unroll
                for (int bj = 0; bj < 2; ++bj) { const f32x4 v0 = acc[ai][bj][m][0] * scale, v1 = acc[ai][bj][m][1] * scale;
                    u32x4 w; w.x = cvt_pk_bf16(v0[0], v0[1]); w.y = cvt_pk_bf16(v0[2], v0[3]); w.z = cvt_pk_bf16(v1[0], v1[1]); w.w = cvt_pk_bf16(v1[2], v1[3]);
                    *(u32x4*)(rowp + bj * HALF) = w; } }
        if (u.pn >= 4 && u.pn < 8) {
            float cs[2][8];
#pragma unroll
            for (int bj = 0; bj < 2; ++bj)
#pragma unroll
                for (int j = 0; j < 8; ++j) { float s = 0.f;
#pragma unroll
                    for (int ai = 0; ai < 2; ++ai)
#pragma unroll
                        for (int m = 0; m < 4; ++m) s += acc[ai][bj][m][j >> 2][j & 3];
                    s += __shfl_xor(s, 1); s += __shfl_xor(s, 2); s += __shfl_xor(s, 4); s += __shfl_xor(s, 8);
                    cs[bj][j] = s; }
            if (fr == 0) { const int b = u.pm >> 4, nb = u.pm & 15;
#pragma unroll
                for (int bj = 0; bj < 2; ++bj)
#pragma unroll
                    for (int j = 0; j < 8; ++j) { const int col = 128 * bj + 32 * wc + 8 * fq + j, h = 2 * (u.pn - 4) + (col >> 7), d = col & 127;
                        atomicAdd(kmean + (size_t)((b * 8 + h) * 16 + nb) * 128 + d, cs[bj][j] * (scale * (1.0f / 256.0f))); } }
        }
    }
};
struct EpiResF32X {
    static constexpr bool PERM = false;
    const float* base; float* out; int ldc; bf16_t* xb; float* ss; unsigned char* x8; const float* gain; int ld8;
    __device__ __forceinline__ void operator()(const f32x4 (&acc)[2][2][4][2], const Unit& u, int wr, int wc, int fr, int fq) const {
        const int row0 = u.pm * BM + wr * 64 + fr, col0 = u.pn * BM + wc * 32 + 4 * fq;
        f32x4 gv[2][2];
#pragma unroll
        for (int bj = 0; bj < 2; ++bj)
#pragma unroll
            for (int n = 0; n < 2; ++n) gv[bj][n] = *(const f32x4*)(gain + col0 + bj * HALF + n * 16);
#pragma unroll
        for (int ai = 0; ai < 2; ++ai) {
            f32x4 bs[4][2][2];
#pragma unroll
            for (int m = 0; m < 4; ++m) { const size_t off = (size_t)(row0 + ai * HALF + m * 16) * ldc + col0;
#pragma unroll
                for (int bj = 0; bj < 2; ++bj)
#pragma unroll
                    for (int n = 0; n < 2; ++n) bs[m][bj][n] = *(const f32x4*)(base + off + bj * HALF + n * 16); }
            asm volatile("" ::: "memory");
#pragma unroll
            for (int m = 0; m < 4; ++m) { const int r = row0 + ai * HALF + m * 16; const size_t off = (size_t)r * ldc + col0; float s2 = 0.f;
#pragma unroll
                for (int bj = 0; bj < 2; ++bj)
#pragma unroll
                    for (int n = 0; n < 2; ++n) { const f32x4 x = bs[m][bj][n] + acc[ai][bj][m][n];
                        if (out) *(f32x4*)(out + off + bj * HALF + n * 16) = x; s2 += (x[0] * x[0] + x[1] * x[1]) + (x[2] * x[2] + x[3] * x[3]);
                        u32x2 w; w.x = cvt_pk_bf16(x[0], x[1]); w.y = cvt_pk_bf16(x[2], x[3]); *(u32x2*)(xb + off + bj * HALF + n * 16) = w;
                        const f32x4 g = gv[bj][n]; *(unsigned*)(x8 + (size_t)r * ld8 + col0 + bj * HALF + n * 16) = pk4_fp8(x[0] * g[0], x[1] * g[1], x[2] * g[2], x[3] * g[3]); }
                s2 += __shfl_xor(s2, 16); s2 += __shfl_xor(s2, 32);
                if (fq == 0) ss[(size_t)r * 32 + u.pn * 4 + wc] = s2; }
        }
    }
};
struct EpiXQ {
    static constexpr bool PERM = true;
    bf16_t* O; int ldc; const float* ss; float eps; float scale;
    __device__ __forceinline__ void operator()(const f32x4 (&acc)[2][2][4][2], const Unit& u, int wr, int wc, int fr, int fq) const {
        const int row0 = u.pm * BM + wr * 64 + fr, col0 = u.pn * BM + wc * 32 + 8 * fq;
#pragma unroll
        for (int ai = 0; ai < 2; ++ai)
#pragma unroll
            for (int m = 0; m < 4; ++m) { const int r = row0 + ai * HALF + m * 16; float s = 0.f;
#pragma unroll
                for (int j = 0; j < 8; ++j) { const f32x4 t = *(const f32x4*)(ss + (size_t)r * 32 + 4 * j); s += (t[0] + t[1]) + (t[2] + t[3]); }
                const float rstd = scale / sqrtf(s * (1.0f / 2048.0f) + eps);
                bf16_t* rowp = O + (size_t)r * ldc + col0;
#pragma unroll
                for (int bj = 0; bj < 2; ++bj) { const f32x4 v0 = acc[ai][bj][m][0] * rstd, v1 = acc[ai][bj][m][1] * rstd;
                    u32x4 w; w.x = cvt_pk_bf16(v0[0], v0[1]); w.y = cvt_pk_bf16(v0[2], v0[3]); w.z = cvt_pk_bf16(v1[0], v1[1]); w.w = cvt_pk_bf16(v1[2], v1[3]);
                    *(u32x4*)(rowp + bj * HALF) = w; } }
    }
};
__device__ __forceinline__ float swiglu_(float g, float up) { g = fminf(g, 7.0f); up = fminf(fmaxf(up, -7.0f), 7.0f); return (up + 1.0f) * g * sigmoidf_(1.702f * g); }
__device__ __forceinline__ unsigned pk4_fp8(float a, float b, float c, float d) { int w = 0; w = __builtin_amdgcn_cvt_pk_fp8_f32(a, b, w, false); w = __builtin_amdgcn_cvt_pk_fp8_f32(c, d, w, true); return (unsigned)w; }
constexpr float W8_SCALE = 64.0f, W8_INV = 1.0f / 64.0f;
struct EpiGU {
    static constexpr bool PERM = true;
    const float* bias; unsigned char* ACT; int lda;
    __device__ __forceinline__ void operator()(const f32x4 (&acc)[2][2][4][2], const Unit& u, int wr, int wc, int fr, int fq) const {
        const int row0 = u.pm * BM + wr * 64 + fr, col0 = u.pn * BM + wc * 32 + 8 * fq;
        f32x4 bv[2][2];
#pragma unroll
        for (int bj = 0; bj < 2; ++bj)
#pragma unroll
            for (int n = 0; n < 2; ++n) bv[bj][n] = *(const f32x4*)(bias + (size_t)u.e * 4096 + col0 + bj * HALF + 4 * n);
#pragma unroll
        for (int ai = 0; ai < 2; ++ai)
#pragma unroll
            for (int m = 0; m < 4; ++m) { unsigned char* rowp = ACT + (size_t)(row0 + ai * HALF + m * 16) * lda + (col0 >> 1);
#pragma unroll
                for (int bj = 0; bj < 2; ++bj) { if (!((u.bjm >> bj) & 1)) continue; const f32x4 v0 = acc[ai][bj][m][0] * W8_INV + bv[bj][0], v1 = acc[ai][bj][m][1] * W8_INV + bv[bj][1];
                    *(unsigned*)(rowp + bj * (HALF / 2)) = pk4_fp8(swiglu_(v0[0], v0[1]), swiglu_(v0[2], v0[3]), swiglu_(v1[0], v1[1]), swiglu_(v1[2], v1[3])); } }
    }
};
struct EpiDown {
    static constexpr bool PERM = true;
    const float* bias; const float* cw; int cap; bf16_t* Y;
    __device__ __forceinline__ void operator()(const f32x4 (&acc)[2][2][4][2], const Unit& u, int wr, int wc, int fr, int fq) const {
        const int row0 = u.pm * BM + wr * 64 + fr, col0 = u.pn * BM + wc * 32 + 8 * fq, lrow0 = u.lrow0 + wr * 64 + fr;
        f32x4 bv[2][2];
#pragma unroll
        for (int bj = 0; bj < 2; ++bj)
#pragma unroll
            for (int n = 0; n < 2; ++n) bv[bj][n] = *(const f32x4*)(bias + (size_t)u.e * 2048 + col0 + bj * HALF + 4 * n);
#pragma unroll
        for (int ai = 0; ai < 2; ++ai)
#pragma unroll
            for (int m = 0; m < 4; ++m) { const int lr = lrow0 + ai * HALF + m * 16; const float s = lr < u.cnt ? cw[(size_t)u.e * cap + lr] : 0.f;
                bf16_t* rowp = Y + (size_t)(row0 + ai * HALF + m * 16) * 2048 + col0;
#pragma unroll
                for (int bj = 0; bj < 2; ++bj) { if (!((u.bjm >> bj) & 1)) continue; const f32x4 v0 = (acc[ai][bj][m][0] * W8_INV + bv[bj][0]) * s, v1 = (acc[ai][bj][m][1] * W8_INV + bv[bj][1]) * s;
                    u32x4 w; w.x = cvt_pk_bf16(v0[0], v0[1]); w.y = cvt_pk_bf16(v0[2], v0[3]); w.z = cvt_pk_bf16(v1[0], v1[1]); w.w = cvt_pk_bf16(v1[2], v1[3]);
                    *(u32x4*)(rowp + bj * HALF) = w; } }
    }
};

template <class Epi, class Sched, bool ALIGN_EPI, bool GATHER, bool FP8 = false>
__device__ __forceinline__ void gemm_phase(PG8_LAS unsigned char* lds, const Gemm g, const Sched& S, const Epi& E, const int tid) {
    const int wid = __builtin_amdgcn_readfirstlane(tid >> 6), lane = tid & 63, wr = wid >> 2, wc = wid & 3, fr = lane & 15, fq = lane >> 4;
    const int K = g.K, RB = FP8 ? K : 2 * K, nt = RB / (2 * BK);
    const int RBA = g.lda ? g.lda : RB, RBB = g.ldb ? g.ldb : RB;
    int sR[2], sC[2];
    unsigned voffA[2], voffB[2];
#pragma unroll
    for (int i = 0; i < 2; ++i) { int R, C; stage_rc(tid * 16 + i * 8192, R, C); const int Rb = Epi::PERM ? ((R & ~31) + perm32(R & 31)) : R;
        sR[i] = R; sC[i] = C; voffA[i] = (unsigned)(R * RBA + C * 2); voffB[i] = (unsigned)(Rb * RBB + C * 2); }
    const size_t kstep = (size_t)(BK * 2);
    const size_t hstepB = (size_t)HALF * RBB;
    const size_t hstepA = GATHER ? 0 : (size_t)HALF * RBA;
    const size_t tstepA = (size_t)BM * RBA, tstep = 2 * hstepB;
    const unsigned ldsw = (unsigned)wid * 1024u;
    const int aoff = lds_byte(wr * 64 + fr, fq * 8), boff = lds_byte(wc * 32 + fr, fq * 8);
    unsigned cv[2][2], nv[2][2];
#define PG8_SA(b, h) (((b) * 2 + (h)) * HTB)
#define PG8_SB(b, h) ((4 + (b) * 2 + (h)) * HTB)
#define PG8_STAGE(bufoff, gbase, voff) do { _Pragma("unroll") for (int _i = 0; _i < 2; ++_i) \
        __builtin_amdgcn_global_load_lds((const unsigned*)((const char*)(gbase) + (voff)[_i]), (PG8_LAS unsigned*)(lds + (bufoff) + ldsw + _i * 8192), 16, 0, 0); } while (0)
#define PG8_STAGE_A(bufoff, gbase, h, nx) do { if constexpr (GATHER) { _Pragma("unroll") for (int _i = 0; _i < 2; ++_i) { const unsigned vo_ = (nx) ? nv[h][_i] : cv[h][_i]; \
        __builtin_amdgcn_global_load_lds((const unsigned*)((const char*)(gbase) + vo_), (PG8_LAS unsigned*)(lds + (bufoff) + ldsw + _i * 8192), 16, 0, 0); } } \
        else { PG8_STAGE(bufoff, (const char*)(gbase) + (h) * hstepA, voffA); } } while (0)
#define PG8_LD8(addr) __builtin_shufflevector(*(const PG8_LAS i32x4*)(addr), *(const PG8_LAS i32x4*)((addr) + 1024), 0, 1, 2, 3, 4, 5, 6, 7)
#define PG8_LDA(dst, b, h) do { if constexpr (FP8) { _Pragma("unroll") for (int m = 0; m < 4; ++m) dst##8[m] = PG8_LD8(lds + PG8_SA(b, h) + aoff + m * 2048); } \
        else { _Pragma("unroll") for (int m = 0; m < 4; ++m) _Pragma("unroll") for (int k = 0; k < 2; ++k) dst[m][k] = *(const PG8_LAS bf16x8*)(lds + PG8_SA(b, h) + aoff + m * 2048 + k * 1024); } } while (0)
#define PG8_LDB(dst, b, h) do { if constexpr (FP8) { _Pragma("unroll") for (int n = 0; n < 2; ++n) dst##8[n] = PG8_LD8(lds + PG8_SB(b, h) + boff + n * 2048); } \
        else { _Pragma("unroll") for (int n = 0; n < 2; ++n) _Pragma("unroll") for (int k = 0; k < 2; ++k) dst[n][k] = *(const PG8_LAS bf16x8*)(lds + PG8_SB(b, h) + boff + n * 2048 + k * 1024); } } while (0)
#define PG8_MMA(ai, bj, At, Bt) do { __builtin_amdgcn_s_setprio(1); \
        if constexpr (FP8) { _Pragma("unroll") for (int m = 0; m < 4; ++m) _Pragma("unroll") for (int n = 0; n < 2; ++n) \
            asm volatile("v_mfma_scale_f32_16x16x128_f8f6f4 %0, %1, %2, %0, %3, %3 op_sel_hi:[0,0,0]" : "+v"(acc[ai][bj][m][n]) : "v"(Bt##8[n]), "v"(At##8[m]), "v"(mxs)); } \
        else { _Pragma("unroll") for (int m = 0; m < 4; ++m) _Pragma("unroll") for (int n = 0; n < 2; ++n) _Pragma("unroll") for (int k = 0; k < 2; ++k) \
            acc[ai][bj][m][n] = __builtin_amdgcn_mfma_f32_16x16x32_bf16(Bt[n][k], At[m][k], acc[ai][bj][m][n], 0, 0, 0); } __builtin_amdgcn_s_setprio(0); } while (0)
#define PG8_WAIT_V(n) asm volatile("s_waitcnt vmcnt(" #n ")" ::: "memory")
#define PG8_WAIT_L(n) asm volatile("s_waitcnt lgkmcnt(" #n ")" ::: "memory")
#define PG8_BAR __builtin_amdgcn_s_barrier()
#define PG8_SCHED __builtin_amdgcn_sched_barrier(0)
#define PG8_GOFF(dst, u) do { if constexpr (GATHER) { _Pragma("unroll") for (int _h = 0; _h < 2; ++_h) _Pragma("unroll") for (int _i = 0; _i < 2; ++_i) \
        dst[_h][_i] = (unsigned)(S.arow(u, _h * HALF + sR[_i]) * RBA + sC[_i] * 2); } } while (0)
    Unit cur, nxt; int ui = 0;
    if (!S.next(0, cur)) return;
    f32x4 acc[2][2][4][2];
#pragma unroll
    for (int a = 0; a < 2; ++a)
#pragma unroll
        for (int b = 0; b < 2; ++b)
#pragma unroll
            for (int m = 0; m < 4; ++m)
#pragma unroll
                for (int n = 0; n < 2; ++n) acc[a][b][m][n] = (f32x4){0.f, 0.f, 0.f, 0.f};
    const int mxs = 0x7F7F7F7F;
    bf16x8 At[4][2], B0[2][2], B1[2][2]; i32x8 At8[4], B08[2], B18[2];
    const char* cA = GATHER ? (const char*)g.A : (const char*)g.A + (size_t)cur.pm * tstepA; const char* cB = (const char*)g.Bt + (size_t)cur.pb * tstep;
    PG8_GOFF(cv, cur);
#pragma unroll
    for (int _h = 0; _h < 2; ++_h)
#pragma unroll
        for (int _i = 0; _i < 2; ++_i) nv[_h][_i] = cv[_h][_i];
    PG8_STAGE(PG8_SB(0, 0), cB, voffB); PG8_STAGE(PG8_SB(0, 1), cB + hstepB, voffB); PG8_STAGE_A(PG8_SA(0, 0), cA, 0, false); PG8_STAGE_A(PG8_SA(0, 1), cA, 1, false);
    if (wr == 1) PG8_BAR;
    PG8_WAIT_V(2); PG8_BAR;
    PG8_STAGE(PG8_SB(1, 0), cB + kstep, voffB); PG8_STAGE_A(PG8_SA(1, 0), cA + kstep, 0, false); PG8_STAGE(PG8_SB(1, 1), cB + hstepB + kstep, voffB);
    PG8_WAIT_V(6); PG8_BAR;
    for (;;) {
        const bool has_next = S.next(ui + 1, nxt);
        if (has_next) PG8_GOFF(nv, nxt);
        const char* nA = GATHER ? (const char*)g.A : (has_next ? (const char*)g.A + (size_t)nxt.pm * tstepA : cA); const char* nB = has_next ? (const char*)g.Bt + (size_t)nxt.pb * tstep : cB;
        bool act0 = true, act1 = true;
        bool b0on = true, b1on = true;
        if constexpr (sched_rowskip<Sched>::value) { const int vr = cur.cnt - cur.lrow0; act0 = wr * 64 < vr; act1 = HALF + wr * 64 < vr; b0on = (cur.bjm & 1) != 0; b1on = (cur.bjm & 2) != 0; }
        for (int t = 0; t < nt; t += 2) {
            const bool last = (t == nt - 2);
            const char* a1 = cA + (size_t)(t + 1) * kstep;
            const char* a2 = last ? nA : cA + (size_t)(t + 2) * kstep; const char* b2 = last ? nB : cB + (size_t)(t + 2) * kstep;
            const char* a3 = a2 + kstep; const char* b3 = b2 + kstep;
            const bool nx = last && has_next;
            if (act0) { if (b0on) PG8_LDB(B0, 0, 0); if (b1on) PG8_LDB(B1, 0, 1); PG8_SCHED; PG8_LDA(At, 0, 0); } PG8_STAGE_A(PG8_SA(1, 1), a1, 1, false);
            PG8_WAIT_V(8); PG8_WAIT_L(0); PG8_BAR; if (act0) { if (b0on) PG8_MMA(0, 0, At, B0); if (b1on) PG8_MMA(0, 1, At, B1); } PG8_BAR; PG8_SCHED;
            if (act1) { PG8_LDA(At, 0, 1); } PG8_STAGE(PG8_SB(0, 0), b2, voffB); PG8_STAGE(PG8_SB(0, 1), b2 + hstepB, voffB); PG8_STAGE_A(PG8_SA(0, 0), a2, 0, nx);
            PG8_WAIT_V(8); PG8_WAIT_L(0); PG8_BAR; if (act1) { if (b0on) PG8_MMA(1, 0, At, B0); if (b1on) PG8_MMA(1, 1, At, B1); } PG8_BAR; PG8_SCHED;
            if (act0) { if (b0on) PG8_LDB(B0, 1, 0); if (b1on) PG8_LDB(B1, 1, 1); PG8_SCHED; PG8_LDA(At, 1, 0); } PG8_STAGE_A(PG8_SA(0, 1), a2, 1, nx);
            PG8_WAIT_V(8); PG8_WAIT_L(0); PG8_BAR; if (act0) { if (b0on) PG8_MMA(0, 0, At, B0); if (b1on) PG8_MMA(0, 1, At, B1); } PG8_BAR; PG8_SCHED;
            if (act1) { PG8_LDA(At, 1, 1); } PG8_STAGE(PG8_SB(1, 0), b3, voffB); PG8_STAGE(PG8_SB(1, 1), b3 + hstepB, voffB); PG8_STAGE_A(PG8_SA(1, 0), a3, 0, nx);
            PG8_WAIT_V(8); PG8_WAIT_L(0); PG8_BAR; if (act1) { if (b0on) PG8_MMA(1, 0, At, B0); if (b1on) PG8_MMA(1, 1, At, B1); } PG8_BAR; PG8_SCHED;
        }
        if constexpr (ALIGN_EPI) { if (wr == 0) PG8_BAR; }
        if constexpr (FP8) {
            asm volatile("s_nop 15\n\ts_nop 15" : "+v"(acc[0][0][0][0]), "+v"(acc[0][0][0][1]), "+v"(acc[0][0][1][0]), "+v"(acc[0][0][1][1]), "+v"(acc[0][0][2][0]), "+v"(acc[0][0][2][1]), "+v"(acc[0][0][3][0]), "+v"(acc[0][0][3][1]),
                                                   "+v"(acc[0][1][0][0]), "+v"(acc[0][1][0][1]), "+v"(acc[0][1][1][0]), "+v"(acc[0][1][1][1]), "+v"(acc[0][1][2][0]), "+v"(acc[0][1][2][1]), "+v"(acc[0][1][3][0]), "+v"(acc[0][1][3][1]));
            asm volatile("" : "+v"(acc[1][0][0][0]), "+v"(acc[1][0][0][1]), "+v"(acc[1][0][1][0]), "+v"(acc[1][0][1][1]), "+v"(acc[1][0][2][0]), "+v"(acc[1][0][2][1]), "+v"(acc[1][0][3][0]), "+v"(acc[1][0][3][1]),
                              "+v"(acc[1][1][0][0]), "+v"(acc[1][1][0][1]), "+v"(acc[1][1][1][0]), "+v"(acc[1][1][1][1]), "+v"(acc[1][1][2][0]), "+v"(acc[1][1][2][1]), "+v"(acc[1][1][3][0]), "+v"(acc[1][1][3][1])); }
        E(acc, cur, wr, wc, fr, fq);
        if (!has_next) break;
#pragma unroll
        for (int a = 0; a < 2; ++a)
#pragma unroll
            for (int b = 0; b < 2; ++b)
#pragma unroll
                for (int m = 0; m < 4; ++m)
#pragma unroll
                    for (int n = 0; n < 2; ++n) acc[a][b][m][n] = (f32x4){0.f, 0.f, 0.f, 0.f};
        cur = nxt; cA = nA; cB = nB; ++ui;
#pragma unroll
        for (int _h = 0; _h < 2; ++_h)
#pragma unroll
            for (int _i = 0; _i < 2; ++_i) cv[_h][_i] = nv[_h][_i];
        if constexpr (ALIGN_EPI) { if (wr == 1) PG8_BAR; }
    }
    PG8_WAIT_V(0);
    if constexpr (!ALIGN_EPI) { if (wr == 0) PG8_BAR; }
    PG8_BAR;
#undef PG8_SA
#undef PG8_SB
#undef PG8_STAGE
#undef PG8_STAGE_A
#undef PG8_LDA
#undef PG8_LD8
#undef PG8_LDB
#undef PG8_MMA
#undef PG8_WAIT_V
#undef PG8_WAIT_L
#undef PG8_BAR
#undef PG8_SCHED
#undef PG8_GOFF
}
}
namespace att {
typedef unsigned short bf16;
typedef short bf16x8 __attribute__((ext_vector_type(8)));
typedef short s16x4 __attribute__((ext_vector_type(4)));
typedef float f32x16 __attribute__((ext_vector_type(16)));
typedef float f32x4 __attribute__((ext_vector_type(4)));
typedef unsigned u32x4 __attribute__((ext_vector_type(4)));
constexpr int D = 128;
constexpr float SCALE = 0.08838834764831845f;
constexpr float THR = 8.f;
constexpr int NW = 8, QBLK = 32, KVBLK = 64, QB = NW * QBLK;
constexpr int SHM_V = KVBLK * D * 2, SHM_K = KVBLK * D * 2;
constexpr int LDS_WS_OFF = 2 * SHM_V + 2 * SHM_K, LDS_LUT_OFF = LDS_WS_OFF + NW * 64 * 4, LDS_BYTES = LDS_LUT_OFF + 128 * 4;

#define KSWZ(row, colB) ((row) * 256 + ((colB) ^ (((row) & 7) << 4)))
#define SBAR() __builtin_amdgcn_sched_barrier(0)
__device__ __forceinline__ int v_st(int k, int c) { const int kk = (k & ~0xC) | ((k & 4) << 1) | ((k & 8) >> 1); return ((kk >> 3) * 4 + (c >> 5)) * 512 + ((kk & 7) * 32 + (c & 31)) * 2; }
__device__ __forceinline__ int v_rd_base(int lane) { return ((lane & 3) << 3) | (((lane >> 2) & 3) << 6) | (((lane >> 4) & 1) << 5) | (((lane >> 5) & 1) << 8); }
constexpr int v_rd_off(int d0, int ks, int half) { return d0 * 512 + ks * 4096 + half * 2048; }
__device__ __forceinline__ int crow(int r, int hi) { return (r & 3) + 8 * (r >> 2) + 4 * hi; }
__device__ __forceinline__ unsigned cvtpk(float lo, float hi) { unsigned r; asm volatile("v_cvt_pk_bf16_f32 %0, %1, %2" : "=v"(r) : "v"(lo), "v"(hi)); return r; }
__device__ __forceinline__ bf16x8 load8(const bf16* p) { return *reinterpret_cast<const bf16x8*>(p); }

__device__ __forceinline__ void bias_mask_tile(f32x16& p0, f32x16& p1, int dq, const float* lut) {
    const float NEG = -__builtin_inff();
#pragma unroll
    for (int r = 0; r < 16; ++r) {
        const int c = (r & 3) + 8 * (r >> 2);
        const int d0 = dq - c, d1 = dq - c - 32;
        const float b0 = lut[d0 < 0 ? 0 : (d0 > 127 ? 127 : d0)], b1 = lut[d1 < 0 ? 0 : (d1 > 127 ? 127 : d1)];
        p0[r] = d0 < 0 ? NEG : p0[r] + b0;
        p1[r] = d1 < 0 ? NEG : p1[r] + b1;
        if ((r & 3) == 3) asm volatile("" ::: "memory");
    }
}
__device__ __forceinline__ void partialSM(f32x16& p0, f32x16& p1, float& m_reg, float& mn, float& alpha, bool on) {
    float pmax = p0[0]; for (int r = 1; r < 16; ++r) pmax = fmaxf(pmax, p0[r]); for (int r = 0; r < 16; ++r) pmax = fmaxf(pmax, p1[r]);
    { auto rr = __builtin_amdgcn_permlane32_swap(__float_as_uint(pmax), __float_as_uint(pmax), false, false);
      pmax = fmaxf(__uint_as_float(rr[0]), __uint_as_float(rr[1])); }
    pmax = on ? pmax : -__builtin_inff();
    constexpr float C2 = 1.4426950408889634f * SCALE;
    if (__builtin_expect(__all((pmax - m_reg) * SCALE <= THR), 1)) { mn = m_reg; alpha = 1.f; }
    else { mn = fmaxf(m_reg, pmax); alpha = __builtin_amdgcn_exp2f((m_reg - mn) * C2); m_reg = mn; }
    const float mnL = on ? -mn * C2 : -__builtin_inff();
    for (int r = 0; r < 16; ++r) p0[r] = fmaf(p0[r], C2, mnL); for (int r = 0; r < 16; ++r) p1[r] = fmaf(p1[r], C2, mnL);
    for (int r = 0; r < 16; ++r) p0[r] = __builtin_amdgcn_exp2f(p0[r]);
}
__device__ __forceinline__ void finishSM(f32x16& p0, f32x16& p1, float alpha, float& l_reg, bf16x8& pa0, bf16x8& pa1, bf16x8& pa2, bf16x8& pa3) {
    for (int r = 0; r < 16; ++r) p1[r] = __builtin_amdgcn_exp2f(p1[r]);
    float ps = 0; for (int r = 0; r < 16; ++r) ps += p0[r]; for (int r = 0; r < 16; ++r) ps += p1[r];
    { auto rr = __builtin_amdgcn_permlane32_swap(__float_as_uint(ps), __float_as_uint(ps), false, false);
      ps = __uint_as_float(rr[0]) + __uint_as_float(rr[1]); }
    l_reg = l_reg * alpha + ps;
#define PK4(P, B_, OUT) do { unsigned a0 = cvtpk(P[B_+0], P[B_+1]), a1 = cvtpk(P[B_+2], P[B_+3]);                          \
        unsigned b0 = cvtpk(P[B_+4], P[B_+5]), b1 = cvtpk(P[B_+6], P[B_+7]);                                             \
        auto r0 = __builtin_amdgcn_permlane32_swap(a0, b0, false, false); auto r1 = __builtin_amdgcn_permlane32_swap(a1, b1, false, false); \
        u32x4 w = {r0[0], r1[0], r0[1], r1[1]}; OUT = *reinterpret_cast<bf16x8*>(&w); } while (0)
    PK4(p0, 0, pa0); PK4(p0, 8, pa1); PK4(p1, 0, pa2); PK4(p1, 8, pa3);
#undef PK4
}
template <int KB>
__device__ __forceinline__ void qkt(f32x16& p0, f32x16& p1, const char* K_lds, int r32, int hi, const bf16x8* qr) {
    p0 = f32x16{}; p1 = f32x16{};
    const char* kb[4];
#pragma unroll
    for (int dd = 0; dd < 4; ++dd) kb[dd] = K_lds + KB * SHM_K + KSWZ(r32, (dd * 16 + hi * 8) * 2);
#pragma unroll
    for (int d0 = 0; d0 < 8; ++d0) { const char* a = kb[d0 & 3] + (d0 >> 2) * 128;
        bf16x8 b0 = *reinterpret_cast<const bf16x8*>(a);
        bf16x8 b1 = *reinterpret_cast<const bf16x8*>(a + 32 * 256);
        p0 = __builtin_amdgcn_mfma_f32_32x32x16_bf16(b0, qr[d0], p0, 0, 0, 0);
        p1 = __builtin_amdgcn_mfma_f32_32x32x16_bf16(b1, qr[d0], p1, 0, 0, 0); }
}
template <int VB>
__device__ __forceinline__ void pv_tile(f32x16* o, int vb0, bf16x8 pa0, bf16x8 pa1, bf16x8 pa2, bf16x8 pa3) {
#define TRRD(dst, off) asm volatile("ds_read_b64_tr_b16 %0, %1 offset:%2" : "=&v"(dst) : "v"(vb0), "i"(off) : "memory")
#define PV_D0(d0) do { s16x4 l0, l1, l2, l3, h0, h1, h2, h3; constexpr int b_ = VB * SHM_V + v_rd_off(d0, 0, 0);     \
        TRRD(l0, b_); TRRD(h0, b_ + 2048); TRRD(l1, b_ + 4096); TRRD(h1, b_ + 6144); TRRD(l2, b_ + 8192); TRRD(h2, b_ + 10240); TRRD(l3, b_ + 12288); TRRD(h3, b_ + 14336); \
        asm volatile("s_waitcnt lgkmcnt(0)" ::: "memory"); SBAR();                 \
        o[d0] = __builtin_amdgcn_mfma_f32_32x32x16_bf16(pa0, (bf16x8){l0[0], l0[1], l0[2], l0[3], h0[0], h0[1], h0[2], h0[3]}, o[d0], 0, 0, 0);   \
        o[d0] = __builtin_amdgcn_mfma_f32_32x32x16_bf16(pa1, (bf16x8){l1[0], l1[1], l1[2], l1[3], h1[0], h1[1], h1[2], h1[3]}, o[d0], 0, 0, 0);   \
        o[d0] = __builtin_amdgcn_mfma_f32_32x32x16_bf16(pa2, (bf16x8){l2[0], l2[1], l2[2], l2[3], h2[0], h2[1], h2[2], h2[3]}, o[d0], 0, 0, 0);   \
        o[d0] = __builtin_amdgcn_mfma_f32_32x32x16_bf16(pa3, (bf16x8){l3[0], l3[1], l3[2], l3[3], h3[0], h3[1], h3[2], h3[3]}, o[d0], 0, 0, 0); } while (0)
    PV_D0(0); PV_D0(1); PV_D0(2); PV_D0(3);
#undef PV_D0
#undef TRRD
}

struct BlockRef { const bf16* Q; const bf16* K; const bf16* V; bf16* O; const float* lut; const unsigned short* sel; int ldq, ldkv, ldo, P0, nkt; };
struct Seam { bf16x8 qr[8]; bf16x8 st_v0, st_v1, st_k0, st_k1; };
#define ROWK(p, k0, rr) ((p) + (size_t)((k0) + (rr)) * ldkv + sc)
#define VMW() asm volatile("s_waitcnt vmcnt(0)" ::: "memory")
#define VMWN(n) asm volatile("s_waitcnt vmcnt(%0)" :: "i"(n) : "memory")
#define SLOAD_H(Kp, Vp, k0) do { S.st_v0 = load8(ROWK(Vp, k0, sr)); S.st_v1 = load8(ROWK(Vp, k0, 32 + sr)); S.st_k0 = load8(ROWK(Kp, k0, sr)); S.st_k1 = load8(ROWK(Kp, k0, 32 + sr)); } while (0)
#define SWRITE_HK(bf) do { *(bf16x8*)(K_lds + (bf) * SHM_K + kws) = S.st_k0; *(bf16x8*)(K_lds + (bf) * SHM_K + kws + 32 * 256) = S.st_k1; } while (0)
#define SWRITE_HV(bf) do { *(bf16x8*)(V_lds + (bf) * SHM_V + vst0) = S.st_v0; *(bf16x8*)(V_lds + (bf) * SHM_V + vst1) = S.st_v1; } while (0)
#define SWRITE_H(bf) do { SWRITE_HV(bf); SWRITE_HK(bf); } while (0)
__device__ __forceinline__ void attn_prime(const BlockRef& cur, char* lds, Seam& S, const int tid) {
    const int wid = __builtin_amdgcn_readfirstlane(tid >> 6), lane = tid & 63, r32 = lane & 31, hi = lane >> 5;
    const int sr = tid >> 4, sc = (tid & 15) * 8, kws = KSWZ(sr, sc * 2); char* K_lds = lds + 2 * SHM_V; const int ldkv = cur.ldkv;
    float* lutl = (float*)(lds + LDS_LUT_OFF);
    for (int d0 = 0; d0 < 8; ++d0) S.qr[d0] = load8(cur.Q + (size_t)(wid * QBLK + r32) * cur.ldq + d0 * 16 + hi * 8);
    SLOAD_H(cur.K, cur.V, 0);
    if (tid < 128) lutl[tid] = cur.lut ? cur.lut[tid] : 0.f;
    VMW(); SWRITE_HK(0);
    __syncthreads();
}
template <bool MASK, bool OUT8 = false, class MK>
__device__ __forceinline__ void attn_block(const BlockRef& cur, const int nidx, const MK& mk, char* lds, Seam& S, const int tid) {
    const int wid = __builtin_amdgcn_readfirstlane(tid >> 6), lane = tid & 63, r32 = lane & 31, hi = lane >> 5;
    const int NT = cur.nkt;
    const int qlo = cur.P0 + wid * QBLK, qm = qlo + r32 - 4 * hi;
    char* V_lds = lds; char* K_lds = lds + 2 * SHM_V;
    float* ws = (float*)(lds + LDS_WS_OFF) + wid * 64; float* li_l = ws, * al_l = ws + 32;
    float* lutl = (float*)(lds + LDS_LUT_OFF);
    float m_reg = -1e30f, l_reg = 0; f32x16 o[4] = {};
    const int sr = tid >> 4, sc = (tid & 15) * 8, vst0 = v_st(sr, sc), vst1 = v_st(32 + sr, sc), kws = KSWZ(sr, sc * 2);
    const int vb0 = (int)(uintptr_t)V_lds + v_rd_base(lane);
    const bf16* Kh = cur.K; const bf16* Vh = cur.V; const int ldkv = cur.ldkv;
    const unsigned selq = (MASK && cur.sel) ? (unsigned)cur.sel[wid * QBLK + r32] : 0xffffu;
    const int ownb = cur.P0 >> 8;
#define RESC(a) do { if (__any((a) < 1.f)) { if (hi == 0) al_l[r32] = (a); asm volatile("s_waitcnt lgkmcnt(0)" ::: "memory");              \
                     for (int d_ = 0; d_ < 4; ++d_) for (int r = 0; r < 16; ++r) o[d_][r] *= al_l[crow(r, hi)]; } } while (0)
#define KBASE(t) ((t) * KVBLK)
#define MASKT(P0_, P1_, t) do { if constexpr (MASK) { const int kb_ = KBASE(t); if (__builtin_expect(kb_ + KVBLK + 112 > qlo, 0)) bias_mask_tile(P0_, P1_, qm - kb_, lutl); } } while (0)
#define LANE_ON(t) (!MASK || (((t) >> 2) >= ownb) || ((selq >> ((t) >> 2)) & 1u))
    constexpr int NQL = 8;
#define SEAM_K0() do { VMWN(NQL); SWRITE_HK(0); SBAR(); } while (0)
    f32x16 pA0, pA1, pB0, pB1; float mnA, mnB, alA, alB; bf16x8 pa0, pa1, pa2, pa3;
    SWRITE_HV(0); SBAR();
    SLOAD_H(Kh, Vh, KBASE(1));
    SBAR(); qkt<0>(pA0, pA1, K_lds, r32, hi, S.qr);
    MASKT(pA0, pA1, 0); partialSM(pA0, pA1, m_reg, mnA, alA, LANE_ON(0));
    VMW(); SWRITE_H(1);
    __syncthreads();
#define HALF_STEP(PX0, PX1, mnX, alX, PY0, PY1, alY, t, KB, VB, SB) do {                                                      \
        SBAR(); qkt<KB>(PX0, PX1, K_lds, r32, hi, S.qr);                                                                      \
        finishSM(PY0, PY1, alY, l_reg, pa0, pa1, pa2, pa3); SBAR();                                                           \
        if ((t) + 1 < NT) { SLOAD_H(Kh, Vh, KBASE((t) + 1)); SBAR(); }                                                        \
        pv_tile<VB>(o, vb0, pa0, pa1, pa2, pa3); MASKT(PX0, PX1, (t)); partialSM(PX0, PX1, m_reg, mnX, alX, LANE_ON(t));      \
        __syncthreads();                                                                                                      \
        if ((t) + 1 < NT) { VMW(); SWRITE_H(SB); }                                                                            \
        RESC(alX); __syncthreads(); } while (0)
    for (int t = 1; t + 1 < NT; t += 2) {
        HALF_STEP(pB0, pB1, mnB, alB, pA0, pA1, alA, t, 1, 0, 0);
        HALF_STEP(pA0, pA1, mnA, alA, pB0, pB1, alB, t + 1, 0, 1, 1);
    }
    SBAR(); qkt<1>(pB0, pB1, K_lds, r32, hi, S.qr); SBAR();
    const BlockRef nxt = nidx < 0 ? cur : mk(nidx);
    { const int ldkv = nxt.ldkv; SLOAD_H(nxt.K, nxt.V, 0); } SBAR();
#pragma unroll
    for (int d0 = 0; d0 < 8; ++d0) S.qr[d0] = load8(nxt.Q + (size_t)(wid * QBLK + r32) * nxt.ldq + d0 * 16 + hi * 8);
    SBAR();
    finishSM(pA0, pA1, alA, l_reg, pa0, pa1, pa2, pa3); SBAR();
    pv_tile<0>(o, vb0, pa0, pa1, pa2, pa3);
    MASKT(pB0, pB1, NT - 1); partialSM(pB0, pB1, m_reg, mnB, alB, LANE_ON(NT - 1)); __syncthreads(); RESC(alB);
    finishSM(pB0, pB1, alB, l_reg, pa0, pa1, pa2, pa3); SBAR(); pv_tile<1>(o, vb0, pa0, pa1, pa2, pa3);
    SBAR(); SEAM_K0();
    if (hi == 0) li_l[r32] = l_reg; asm volatile("s_waitcnt lgkmcnt(0)" ::: "memory");
    float rli[16];
#pragma unroll
    for (int r = 0; r < 16; ++r) rli[r] = __builtin_amdgcn_rcpf(li_l[crow(r, hi)]);
    const bool is8 = OUT8 || (MASK && cur.sel != nullptr);
    const int esz = is8 ? 1 : 2; const float osc = OUT8 ? 64.0f : (is8 ? 16.0f : 1.0f);
    unsigned char* Ob = (unsigned char*)cur.O + (size_t)(wid * QBLK) * cur.ldo * esz;
    const bool st_on = is8 ? ((r32 & 3) == 0) : ((r32 & 1) == 0);
#pragma unroll
    for (int r = 0; r < 16; ++r) { const int orow = crow(r, hi); const float sc = rli[r] * osc;
        unsigned char* rowp = Ob + (size_t)orow * cur.ldo * esz + r32 * esz;
#pragma unroll
        for (int d0 = 0; d0 < 4; ++d0) { const float v = o[d0][r] * sc;
            const float vn = __shfl_xor(v, 1);
            unsigned b = (unsigned)__builtin_amdgcn_cvt_pk_fp8_f32(v, vn, 0, false) & 0xffffu;
            b |= (unsigned)__shfl_xor((int)b, 2) << 16;
            const unsigned w = is8 ? b : cvtpk(v, vn);
            if (st_on) *(unsigned*)(rowp + d0 * 32 * esz) = w; } }
    if (MASK && tid < 128) lutl[tid] = nxt.lut ? nxt.lut[tid] : 0.f;
    __syncthreads();
#undef RESC
#undef KBASE
#undef MASKT
#undef LANE_ON
#undef SEAM_K0
#undef HALF_STEP
}
#undef ROWK
#undef VMW
#undef VMWN
#undef SLOAD_H
#undef SWRITE_HK
#undef SWRITE_HV
#undef SWRITE_H
#undef KSWZ
#undef SBAR
}
constexpr int NWAVES = 8;
constexpr int NBATCH = 2, SEQ = 4096, DM = 2048, T = NBATCH * SEQ;
constexpr int NQKV = 10240, LDQKV = NQKV + 128  , C_QA = 0, C_KA = 1024, C_VA = 2048, C_QB = 3072, C_KB = 4096, C_VB = 5120, C_GA = 6144, C_GB = 8192;
constexpr int MEMLEN = 256, NEXP = 32, TOPK = 4, CAP = 8192, MAXROWS = 40960;
constexpr float NORM_EPS = 1e-5f;
constexpr int LD8 = 2048 + 128, OMP = 1024 + 128, OXP = 512 + 128;
constexpr int N_PHASES = 15;
#ifndef MK_ONE_LAUNCH
#define MK_ONE_LAUNCH 1
#endif

constexpr size_t MiB = 1u << 20;
constexpr size_t WS_CTL = 0, CTL_ZERO_BYTES = 128 * 1024;
constexpr size_t WS_LUT = 1 * MiB, WS_TOK = 2 * MiB, WS_CW = 3 * MiB, WS_TSEL = 4 * MiB, WS_SEL = 4 * MiB + 512 * 1024, WS_KMEAN = 5 * MiB, WS_SS = 7 * MiB, WS_WRH = 6 * MiB, WS_WRL = 6 * MiB + 256 * 1024;
constexpr size_t WS_WIN = 8 * MiB, WS_WBM = 48 * MiB, WS_WBD = 52 * MiB, WS_WMIX = 56 * MiB, WS_WXQ = 64 * MiB, WS_WXKV = 66 * MiB, WS_WXO = 70 * MiB, WS_WGU = 72 * MiB, WS_WDN = 584 * MiB;
constexpr size_t WS_H = 840 * MiB, WS_MEMN = 872 * MiB, WS_QKV = 1700 * MiB, WS_OM = 1034 * MiB, WS_ODP = 1050 * MiB, WS_ODN = 1082 * MiB, WS_T1 = 1098 * MiB, WS_MRG = 1130 * MiB;
constexpr size_t WS_H8 = 1162 * MiB, WS_W8 = 1194 * MiB, WS_X1 = 1162 * MiB, WS_HX = 1226 * MiB, WS_QX = 1258 * MiB, WS_KVX = 1266 * MiB, WS_OX = 1268 * MiB, WS_X2 = 1276 * MiB, WS_HF = 1340 * MiB, WS_ACT = 1372 * MiB, WS_Y = 1532 * MiB, WS_END = 1864 * MiB;
constexpr int CW_TMO = 0, CW_BAR = 4096, CW_CNT = 16384;
static_assert((CW_CNT + 64 * NEXP) * 4 <= (int)CTL_ZERO_BYTES, "CTL words inside the memset region");

constexpr int RING_OFF = 0, RING_BYTES = 135168;
constexpr int LDSCTL_OFF = RING_BYTES, TAB_OFF = LDSCTL_OFF, MISC_OFF = LDSCTL_OFF + 1024;
constexpr int LDS_BYTES = 147456;
static_assert(MISC_OFF + 128 <= LDS_BYTES && att::LDS_BYTES <= RING_BYTES && pg8::STAGE_BYTES <= RING_BYTES, "LDS map");

#define GAS __attribute__((address_space(1)))
#define LAS __attribute__((address_space(3)))
typedef unsigned short bf16;
typedef unsigned v4u __attribute__((ext_vector_type(4)));
typedef unsigned v2u __attribute__((ext_vector_type(2)));
typedef float f32x4 __attribute__((ext_vector_type(4)));
typedef GAS unsigned gu32;
#define RLX_AGENT __ATOMIC_RELAXED, __HIP_MEMORY_SCOPE_AGENT
#define LDS_WAIT() asm volatile("s_waitcnt lgkmcnt(0)" ::: "memory")
#define VM_WAIT() asm volatile("s_waitcnt vmcnt(0)" ::: "memory")
__device__ __forceinline__ unsigned f2bf(float f) { unsigned u = __builtin_bit_cast(unsigned, f); return (u + 0x7fffu + ((u >> 16) & 1u)) >> 16; }
__device__ __forceinline__ unsigned pk2(float lo, float hi) { return f2bf(lo) | (f2bf(hi) << 16); }
__device__ __forceinline__ float bflo(unsigned w) { return __builtin_bit_cast(float, w << 16); }
__device__ __forceinline__ float bfhi(unsigned w) { return __builtin_bit_cast(float, w & 0xffff0000u); }

#define XB_TMO      128
#define XB_XCNT(j)  (256  + 64 * (j))
#define XB_XSUB(j)  (1280 + 64 * (j))
#define XB_XGEN(j)  (2304 + 64 * (j))
#define XB_TOP      3328
#define XB_TOPGEN   3392
#define XCD_BAR_WORDS 3456
#define XB_SPIN_CAP (1u << 18)
__device__ __forceinline__ unsigned xb_ld(unsigned* p)              { return __hip_atomic_load(p, __ATOMIC_RELAXED, __HIP_MEMORY_SCOPE_AGENT); }
__device__ __forceinline__ unsigned xb_add(unsigned* p, unsigned v) { return __hip_atomic_fetch_add(p, v, __ATOMIC_RELAXED, __HIP_MEMORY_SCOPE_AGENT); }
__device__ __forceinline__ unsigned xb_xcc_id() { return (unsigned)__builtin_amdgcn_s_getreg((3 << 11) | 20) & 0xFu; }
#define XB_SPIN(cond, bar) do { unsigned _sp = 0; while (cond) { __builtin_amdgcn_s_sleep(1); \
    if ((++_sp & 255u) == 0u) { if (xb_ld(&(bar)[XB_TMO])) break; if (_sp > XB_SPIN_CAP) { atomicAdd(&(bar)[XB_TMO], 1u); break; } } } } while (0)
struct XcdBarrier { unsigned* bar; unsigned x; volatile LAS unsigned* st; };
__device__ __forceinline__ XcdBarrier xcd_barrier_post(unsigned* bar, volatile LAS unsigned* st, const bool t0) {
    XcdBarrier b; b.bar = bar; b.x = xb_xcc_id(); b.st = st;
    if (t0) (void)xb_add(&bar[XB_XCNT(b.x)], 1u);
    return b;
}
__device__ __forceinline__ void xcd_barrier_complete(unsigned* bar, unsigned x, unsigned& nloc, unsigned& nx) {
    const unsigned G = gridDim.x * gridDim.y * gridDim.z;
    unsigned sum, cnt, mine, sp = 0u;
    for (;;) {
        sum = 0u; cnt = 0u; mine = 0u;
#pragma unroll
        for (unsigned j = 0; j < 16; ++j) { const unsigned c = xb_ld(&bar[XB_XCNT(j)]); sum += c; cnt += (c > 0u) ? 1u : 0u; mine = (j == x) ? c : mine; }
        if (sum == G) break;
        __builtin_amdgcn_s_sleep(1);
        if ((++sp & 255u) == 0u) { if (xb_ld(&bar[XB_TMO])) break; if (sp > XB_SPIN_CAP) { atomicAdd(&bar[XB_TMO], 1u); break; } }
    }
    nloc = mine > 0u ? mine : 1u; nx = cnt > 0u ? cnt : 1u;
}
__device__ __forceinline__ void xcd_barrier(const XcdBarrier& b, const bool t0) {
    asm volatile("s_waitcnt vmcnt(0)" ::: "memory");
    __syncthreads();
    if (t0) {
        unsigned* bar = b.bar;
        __builtin_amdgcn_s_waitcnt(0);
        unsigned nloc = b.st[0], nx = b.st[1];
        if (nloc == 0u) { xcd_barrier_complete(bar, b.x, nloc, nx); b.st[0] = nloc; b.st[1] = nx; }
        const unsigned old = xb_add(&bar[XB_XSUB(b.x)], 1u);
        const unsigned gen = old / nloc;
        if (old + 1u == (gen + 1u) * nloc) {
            __builtin_amdgcn_fence(__ATOMIC_RELEASE, "agent");
            asm volatile("s_waitcnt vmcnt(0)" ::: "memory");
            const unsigned og = xb_add(&bar[XB_TOP], 1u);
            const unsigned tg = og / nx;
            if (og + 1u == (tg + 1u) * nx) xb_add(&bar[XB_TOPGEN], 1u);
            else XB_SPIN(xb_ld(&bar[XB_TOPGEN]) == tg, bar);
            __builtin_amdgcn_fence(__ATOMIC_ACQUIRE, "agent");
            xb_add(&bar[XB_XGEN(b.x)], 1u);
            asm volatile("s_waitcnt vmcnt(0)" ::: "memory");
        } else {
            XB_SPIN(xb_ld(&bar[XB_XGEN(b.x)]) == gen, bar);
            __builtin_amdgcn_fence(__ATOMIC_ACQUIRE, "agent");
            asm volatile("s_waitcnt vmcnt(0)" ::: "memory");
        }
    }
    __syncthreads();
}

struct Args { const float* in[27]; float* out; unsigned char* ws; int ph_lo, ph_hi; };
struct Frame {
    LAS unsigned char* lds; char* ldsg;
    volatile LAS unsigned* MISC;
    unsigned* ctl;
    int tid, lane, wave, vcu, G;
};
__device__ __forceinline__ int lane_now() { int l; asm volatile("v_mbcnt_lo_u32_b32 %0, -1, 0\n\tv_mbcnt_hi_u32_b32 %0, -1, %0" : "=v"(l)); return l; }
#define RETID() do { F.lane = lane_now(); F.tid = F.wave * 64 + F.lane; } while (0)
__device__ __forceinline__ float wave_sum(float v) {
#pragma unroll
    for (int o = 1; o < 64; o <<= 1) v += __shfl_xor(v, o);
    return v;
}
__device__ __forceinline__ void rms_row_to_bf16(int lane, const float* xrow, const float* gain, bf16* orow, unsigned char* o8row = nullptr) {
    const GAS f32x4* xr = (const GAS f32x4*)xrow + lane; const GAS f32x4* gr = (const GAS f32x4*)gain + lane;
    f32x4 v[8]; float s2 = 0.f;
#pragma unroll
    for (int j = 0; j < 8; ++j) { v[j] = xr[64 * j]; s2 += (v[j].x * v[j].x + v[j].y * v[j].y) + (v[j].z * v[j].z + v[j].w * v[j].w); }
    const float rstd = 1.f / sqrtf(wave_sum(s2) * (1.f / DM) + NORM_EPS);
    GAS unsigned long long* o8 = (GAS unsigned long long*)orow + lane;
#pragma unroll
    for (int j = 0; j < 8; ++j) { const f32x4 gv = gr[64 * j];
        o8[64 * j] = (unsigned long long)pk2(v[j].x * rstd * gv.x, v[j].y * rstd * gv.y) | ((unsigned long long)pk2(v[j].z * rstd * gv.z, v[j].w * rstd * gv.w) << 32);
        if (o8row) ((GAS unsigned*)o8row)[lane + 64 * j] = pg8::pk4_fp8(v[j].x * rstd * gv.x, v[j].y * rstd * gv.y, v[j].z * rstd * gv.z, v[j].w * rstd * gv.w); }
}
__device__ __forceinline__ int rel_bucket(int d) {
    if (d < 16) return d;
    const int l = 16 + (int)(logf((float)d * (1.0f / 16.0f)) / 2.0794415416798357f * 16.0f);
    return l < 31 ? l : 31;
}
__device__ __forceinline__ void moe_tables(Frame& F) {
    LAS int* tab = (LAS int*)(F.lds + TAB_OFF);
    if (F.tid < 32) tab[64 + F.tid] = (int)__hip_atomic_load(F.ctl + CW_CNT + 64 * F.tid, RLX_AGENT);
    __syncthreads();
    if (F.tid == 0) { int acc = 0; for (int e = 0; e < 32; ++e) { tab[e] = acc; acc += (tab[64 + e] + 255) >> 8; } tab[32] = acc; }
    __syncthreads();
}


typedef const __attribute__((address_space(4))) Args* KArgs;
__device__ __forceinline__ KArgs kargs() { unsigned long long p = (unsigned long long)__builtin_amdgcn_kernarg_segment_ptr(); asm volatile("" : "+s"(p)); return (KArgs)p; }
#define AIN(k) (kargs()->in[k])
struct TrDesc { const float* src; unsigned char* dst; const float* rs; int K, N, f8, ld; };
constexpr int TI_IN = 32 * 48  , TI_BM = 16 * 32, TI_BM8 = 8 * 32  , TI_MIX = 32 * 32, TI_XQ = 16 * 8  , TI_XO = 4 * 32  , TI_GU = 16 * 64, TI_DN = 16 * 32;
constexpr int TI_SMALL = TI_IN + TI_BM8 + TI_BM + TI_MIX + 3 * TI_XQ + TI_XO, TI_TOTAL = TI_SMALL + 32 * (TI_GU + TI_DN);
constexpr int TI_W8 = 16 * 112;
constexpr int TI_SM = TI_SMALL - TI_IN;
constexpr int TI_P10 = 128 * 8 * 2;
constexpr int TI_DEFER = 184 * 8 * 5;
constexpr int P4_ATT_CUS = 224, TI_P4M = 32 * 8 * 34, TI_P4 = TI_SM + TI_P4M, TI_S0 = TI_TOTAL - TI_DEFER - TI_P10 - TI_P4;
constexpr int P1_GEMM_CUS = 160;
constexpr int TR_PITCH = 160, TR_LDS_PER_WAVE = 64 * TR_PITCH;
__device__ __forceinline__ TrDesc tr_make(const float* W, int K, int N, void* WT, int row_off, int item, int f8 = 0, const float* rs = nullptr, int ld = 0) {
    const int nblk = N / 64, kb = item / nblk, nb = item % nblk, k0 = (f8 ? 128 : 64) * kb, n0 = 64 * nb;
    TrDesc d; d.src = W + (size_t)k0 * N + n0; d.ld = ld ? ld : K * (f8 ? 1 : 2); d.dst = (unsigned char*)WT + (size_t)(row_off + n0) * d.ld + (size_t)k0 * (f8 ? 1 : 2); d.K = K; d.N = N; d.f8 = f8; d.rs = rs ? rs + k0 : nullptr; return d;
}
__device__ __forceinline__ TrDesc tr_decode(int it, unsigned char* ws) {
    int r = it;
    if (r >= TI_TOTAL) { r -= TI_TOTAL; const int kb = r / 112, nb = r % 112, j = nb >> 2, gpn = j < 12 ? j : 12 + j;
        TrDesc d; d.src = AIN(4) + (size_t)(128 * kb) * NQKV + gpn * 256 + (nb & 3) * 64; d.ld = LD8; d.dst = (unsigned char*)(ws + WS_W8) + (size_t)(64 * nb) * LD8 + 128 * kb; d.K = 2048; d.N = NQKV; d.f8 = 1; d.rs = nullptr; return d; }
    if (r < TI_IN) { const int kb = r / 48, nl = r % 48, jl = nl >> 2, nb = (12 + jl) * 4 + (nl & 3);
        TrDesc d; d.src = AIN(4) + (size_t)(64 * kb) * NQKV + 64 * nb; d.ld = 4096; d.dst = (unsigned char*)(ws + WS_WIN) + (size_t)(64 * nb) * 4096 + 128 * kb; d.K = 2048; d.N = NQKV; d.f8 = 0; d.rs = nullptr; return d; }
    r -= TI_IN;
    if (r >= TI_S0 - TI_IN && r < TI_S0 - TI_IN + TI_SM) r -= TI_S0 - TI_IN; else r = TI_SM + (r >= TI_S0 - TI_IN ? r - TI_SM : r);
    if (r < TI_BM8) return tr_make(AIN(10), 1024, 2048, (unsigned char*)(ws + WS_WBM), 0, r, 1, nullptr, OMP); r -= TI_BM8;
    if (r < TI_BM) return tr_make(AIN(11), 1024, 2048, (bf16*)(ws + WS_WBD), 0, r); r -= TI_BM;
    if (r < TI_MIX) return tr_make(AIN(12), 2048, 2048, (bf16*)(ws + WS_WMIX), 0, r); r -= TI_MIX;
    if (r < TI_XQ) return tr_make(AIN(15), 2048, 512, (unsigned char*)(ws + WS_WXQ), 0, r, 1, nullptr, LD8); r -= TI_XQ;
    if (r < TI_XQ) return tr_make(AIN(16), 2048, 512, (unsigned char*)(ws + WS_WXKV), 0, r, 1, nullptr, LD8); r -= TI_XQ;
    if (r < TI_XQ) return tr_make(AIN(17), 2048, 512, (unsigned char*)(ws + WS_WXKV), 512, r, 1, nullptr, LD8); r -= TI_XQ;
    if (r < TI_XO) return tr_make(AIN(18), 512, 2048, (unsigned char*)(ws + WS_WXO), 0, r, 1, nullptr, OXP); r -= TI_XO;
    if (r < 32 * TI_GU) { const int e = r / TI_GU; return tr_make(AIN(22) + (size_t)e * 2048 * 4096, 2048, 4096, (unsigned char*)(ws + WS_WGU) + (size_t)e * 4096 * LD8, 0, r % TI_GU, 1, nullptr, LD8); } r -= 32 * TI_GU;
    const int e = r / TI_DN; return tr_make(AIN(24) + (size_t)e * 2048 * 2048, 2048, 2048, (unsigned char*)(ws + WS_WDN) + (size_t)e * 2048 * LD8, 0, r % TI_DN, 1, nullptr, LD8);
}
typedef short v4i16_t __attribute__((ext_vector_type(4)));
__device__ __forceinline__ v2u tr_rd(const LAS unsigned char* p) { return __builtin_bit_cast(v2u, __builtin_amdgcn_ds_read_tr16_b64_v4i16((LAS v4i16_t*)p)); }
__device__ __forceinline__ unsigned cvtpk_hw(float lo, float hi) { unsigned r; asm volatile("v_cvt_pk_bf16_f32 %0, %1, %2" : "=v"(r) : "v"(lo), "v"(hi)); return r; }
template <bool ALLOW8>
__device__ __forceinline__ void tr_run(int first, int stride, int end, unsigned char* ws, LAS unsigned char* scr, int lane) {
    const int l16 = lane & 15, g = lane >> 4, q4 = l16 >> 2, p4 = l16 & 3, godd = g & 1;
    LAS unsigned char* wr = scr + (lane >> 4) * TR_PITCH + l16 * 8;
    const LAS unsigned char* rdA = scr + (q4 + 12 * godd) * TR_PITCH + (16 * (g >> 1) + 4 * p4) * 2;
    const LAS unsigned char* rdB = scr + (q4 + 4 + 4 * godd) * TR_PITCH + (16 * (g >> 1) + 4 * p4) * 2;
    constexpr int OP = 144;
    for (int it = first; it < end; it += stride) {
        const TrDesc d = tr_decode(it, ws);
        if (ALLOW8 && d.f8) {
            TrDesc dc = d; int itc = it;
            const unsigned rdA_ = (unsigned)(uintptr_t)rdA, rdB_ = (unsigned)(uintptr_t)rdB;
            f32x4 vA[16], vB[16];
#define TR_LD16(V, D, K0) do { const unsigned vo_ = (unsigned)(((lane >> 4) * (D).N + 4 * l16) * 4); const char* rb_ = (const char*)((D).src + (size_t)(K0) * (D).N); const size_t rs_ = (size_t)(D).N * 16; \
                _Pragma("unroll") for (int i = 0; i < 16; ++i) V[i] = *(const GAS f32x4*)(rb_ + i * rs_ + vo_); } while (0)
            TR_LD16(vA, dc, 0);
            for (;;) {
                v2u o[2][2][4];
                TR_LD16(vB, dc, 64);
#define TRRD_(dst, base, off) asm volatile("ds_read_b64_tr_b16 %0, %1 offset:%2" : "=&v"(dst) : "v"(base), "i"(off) : "memory")
#define TR_HALF(V, HK) do { const float sc = pg8::W8_SCALE; \
                _Pragma("unroll") for (int i = 0; i < 16; ++i) { v2u w; w.x = cvtpk_hw(V[i].x * sc, V[i].y * sc); w.y = cvtpk_hw(V[i].z * sc, V[i].w * sc); *(LAS v2u*)(wr + 4 * i * TR_PITCH) = w; } \
                LDS_WAIT(); asm volatile("" ::: "memory"); \
                v2u ta_[2][4], tb_[2][4];   \
                _Pragma("unroll") for (int ps = 0; ps < 2; ++ps) _Pragma("unroll") for (int t = 0; t < 4; ++t) { TRRD_(ta_[ps][t], rdA_, 16 * t * TR_PITCH + ps * 64); TRRD_(tb_[ps][t], rdB_, 16 * t * TR_PITCH + ps * 64); } \
                LDS_WAIT(); __builtin_amdgcn_sched_barrier(0); \
                _Pragma("unroll") for (int ps = 0; ps < 2; ++ps) _Pragma("unroll") for (int t = 0; t < 4; ++t) { \
                    const v2u a = ta_[ps][t], b = tb_[ps][t]; const v2u lo = godd ? b : a, hi = godd ? a : b; \
                    o[HK][ps][t].x = pg8::pk4_fp8(bflo(lo.x), bfhi(lo.x), bflo(lo.y), bfhi(lo.y)); o[HK][ps][t].y = pg8::pk4_fp8(bflo(hi.x), bfhi(hi.x), bflo(hi.y), bfhi(hi.y)); } \
                asm volatile("" ::: "memory"); } while (0)
                TR_HALF(vA, 0);
                const int nit = itc + stride; const bool more = nit < end; TrDesc dn = dc; bool chain = false;
                if (more) { dn = tr_decode(nit, ws); chain = dn.f8 != 0;
                    if (chain) TR_LD16(vA, dn, 0); }
                TR_HALF(vB, 1);
#undef TR_HALF
#undef TRRD_
                LAS unsigned char* ow = scr + (16 * (g >> 1) + l16) * OP + 8 * godd;
#pragma unroll
                for (int hk = 0; hk < 2; ++hk)
#pragma unroll
                    for (int ps = 0; ps < 2; ++ps)
#pragma unroll
                        for (int t = 0; t < 4; ++t) *(LAS v2u*)(ow + 32 * ps * OP + 64 * hk + 16 * t) = o[hk][ps][t];
                LDS_WAIT(); asm volatile("" ::: "memory");
#pragma unroll
                for (int j = 0; j < 8; ++j) { const int row = (lane >> 3) + 8 * j, c = lane & 7;
                    const v4u w = *(const LAS v4u*)(scr + row * OP + 16 * c);
                    *(GAS v4u*)(dc.dst + (size_t)row * dc.ld + 16 * c) = w; }
                LDS_WAIT(); asm volatile("" ::: "memory");
                if (!chain) { it = more ? nit - stride : itc; break; }
                dc = dn; itc = nit; it = nit;
            }
            continue;
        }
        {
            const float* s = d.src + (size_t)(lane >> 4) * d.N + 4 * l16;
            f32x4 v[16];
#pragma unroll
            for (int i = 0; i < 16; ++i) v[i] = *(const GAS f32x4*)(s + (size_t)(4 * i) * d.N);
#pragma unroll
            for (int i = 0; i < 16; ++i) { const float sc = d.rs ? d.rs[(lane >> 4) + 4 * i] : 1.0f; v2u w; w.x = cvtpk_hw(v[i].x * sc, v[i].y * sc); w.y = cvtpk_hw(v[i].z * sc, v[i].w * sc); *(LAS v2u*)(wr + 4 * i * TR_PITCH) = w; }
            LDS_WAIT(); asm volatile("" ::: "memory");
            v4u ob[2][4];
#pragma unroll
            for (int ps = 0; ps < 2; ++ps)
#pragma unroll
                for (int t = 0; t < 4; ++t) {
                    const v2u a = tr_rd(rdA + 16 * t * TR_PITCH + ps * 64), b = tr_rd(rdB + 16 * t * TR_PITCH + ps * 64);
                    ob[ps][t].x = godd ? b.x : a.x; ob[ps][t].y = godd ? b.y : a.y; ob[ps][t].z = godd ? a.x : b.x; ob[ps][t].w = godd ? a.y : b.y; }
            LDS_WAIT(); asm volatile("" ::: "memory");
            LAS unsigned char* ow = scr + (16 * (g >> 1) + l16) * OP + 16 * godd;
#pragma unroll
            for (int ps = 0; ps < 2; ++ps)
#pragma unroll
                for (int t = 0; t < 4; ++t) *(LAS v4u*)(ow + 32 * ps * OP + 32 * t) = ob[ps][t];
            LDS_WAIT(); asm volatile("" ::: "memory");
#pragma unroll
            for (int j = 0; j < 8; ++j) { const int row = (lane >> 3) + 8 * j, c = lane & 7;
                const v4u w = *(const LAS v4u*)(scr + row * OP + 16 * c);
                *(GAS v4u*)(d.dst + (size_t)row * d.ld + 16 * c) = w; }
            LDS_WAIT(); asm volatile("" ::: "memory");
        }
    }
}

__device__ __forceinline__ att::BlockRef mk_self_ref(int idx, bf16* QKV, bf16* OM, bf16* ODP, float* LUT, unsigned short* SEL) {
    att::BlockRef r; const int qb = 15 - idx / 48, hs = idx % 48; r.ldq = LDQKV; r.ldkv = LDQKV; r.P0 = qb * 256; r.nkt = 4 * (qb + 1);
    if (hs < 16) { const int b = hs >> 3, h = hs & 7; const size_t row0 = (size_t)b * SEQ;
        r.Q = QKV + (row0 + qb * 256) * LDQKV + C_QA + h * 128; r.K = QKV + row0 * LDQKV + C_KA + h * 128; r.V = QKV + row0 * LDQKV + C_VA + h * 128;
        r.O = (bf16*)((unsigned char*)OM + (row0 + qb * 256) * OMP + h * 128); r.ldo = OMP;     r.lut = LUT + h * 128; r.sel = SEL + (size_t)(b * 8 + h) * SEQ + qb * 256; }
    else { const int d = hs - 16, b = d >> 4, rem = d & 15, h = rem >> 2, i = (rem >> 1) & 1, vh = rem & 1; const size_t row0 = (size_t)b * SEQ;
        r.Q = QKV + (row0 + qb * 256) * LDQKV + C_QB + (h * 2 + i) * 128; r.K = QKV + row0 * LDQKV + C_KB + (h * 2 + i) * 128; r.V = QKV + row0 * LDQKV + C_VB + h * 256 + vh * 128;
        r.O = ODP + (row0 + qb * 256) * 2048 + ((h * 2 + i) * 2 + vh) * 128; r.ldo = 2048; r.lut = LUT + (8 + h) * 128; r.sel = nullptr; }
    return r;
}
__device__ __forceinline__ att::BlockRef mk_cross_ref(int idx, bf16* QX, bf16* KVX, bf16* OX) {
    att::BlockRef r; const int b = idx >> 6, h = (idx >> 4) & 3, qb = idx & 15; const size_t row0 = (size_t)b * SEQ + qb * 256;
    int l512 = 512, l1024 = 1024; asm volatile("" : "+s"(l512), "+s"(l1024));
    r.Q = QX + row0 * 512 + h * 128; r.ldq = l512; r.K = KVX + (size_t)b * MEMLEN * 1024 + h * 128; r.V = r.K + 512; r.ldkv = l1024;
    int lox = OXP; asm volatile("" : "+s"(lox));
    r.O = (bf16*)((unsigned char*)OX + row0 * OXP + h * 128); r.ldo = lox;     r.lut = nullptr; r.sel = nullptr; r.P0 = 1 << 20; r.nkt = 4; return r;
}


static_assert(P4_ATT_CUS == 224, "ATT_LPT is dealt for 224 attention workgroups");
__device__ const short ATT_LPT[224 * 4] = {
    0,400,528,-1, 1,401,529,-1, 2,402,530,-1, 3,403,531,-1, 4,404,532,-1, 5,405,533,-1, 6,406,534,-1, 7,407,535,-1,
    8,408,536,-1, 9,409,537,-1, 10,410,538,-1, 11,411,539,-1, 12,412,540,-1, 13,413,541,-1, 14,414,542,-1, 15,415,543,-1,
    16,416,544,-1, 17,417,545,-1, 18,418,546,-1, 19,419,547,-1, 20,420,548,-1, 21,421,549,-1, 22,422,550,-1, 23,423,551,-1,
    24,424,552,-1, 25,425,553,-1, 26,426,554,-1, 27,427,555,-1, 28,428,556,-1, 29,429,557,-1, 30,430,558,-1, 31,431,559,-1,
    32,432,448,-1, 33,433,449,-1, 34,434,450,-1, 35,435,451,-1, 36,436,452,-1, 37,437,453,-1, 38,438,454,-1, 39,439,455,-1,
    40,440,456,-1, 41,441,457,-1, 42,442,458,-1, 43,443,459,-1, 44,444,460,-1, 45,445,461,-1, 46,446,462,-1, 47,447,463,-1,
    48,352,560,-1, 49,353,561,-1, 50,354,562,-1, 51,355,563,-1, 52,356,564,-1, 53,357,565,-1, 54,358,566,-1, 55,359,567,-1,
    56,360,568,-1, 57,361,569,-1, 58,362,570,-1, 59,363,571,-1, 60,364,572,-1, 61,365,573,-1, 62,366,574,-1, 63,367,575,-1,
    64,368,576,720, 65,369,577,721, 66,370,578,722, 67,371,579,723, 68,372,580,724, 69,373,581,725, 70,374,582,726, 71,375,583,727,
    72,376,584,728, 73,377,585,729, 74,378,586,730, 75,379,587,731, 76,380,588,732, 77,381,589,733, 78,382,590,734, 79,383,591,735,
    80,384,464,-1, 81,385,465,-1, 82,386,466,-1, 83,387,467,-1, 84,388,468,-1, 85,389,469,-1, 86,390,470,-1, 87,391,471,-1,
    88,392,472,-1, 89,393,473,-1, 90,394,474,-1, 91,395,475,-1, 92,396,476,-1, 93,397,477,-1, 94,398,478,-1, 95,399,479,-1,
    96,304,592,736, 97,305,593,737, 98,306,594,738, 99,307,595,739, 100,308,596,740, 101,309,597,741, 102,310,598,742, 103,311,599,743,
    104,312,600,744, 105,313,601,745, 106,314,602,746, 107,315,603,747, 108,316,604,748, 109,317,605,749, 110,318,606,750, 111,319,607,751,
    112,320,608,752, 113,321,609,753, 114,322,610,754, 115,323,611,755, 116,324,612,756, 117,325,613,757, 118,326,614,758, 119,327,615,759,
    120,328,616,760, 121,329,617,761, 122,330,618,762, 123,331,619,763, 124,332,620,764, 125,333,621,765, 126,334,622,766, 127,335,623,767,
    128,336,480,-1, 129,337,481,-1, 130,338,482,-1, 131,339,483,-1, 132,340,484,-1, 133,341,485,-1, 134,342,486,-1, 135,343,487,-1,
    136,344,488,-1, 137,345,489,-1, 138,346,490,-1, 139,347,491,-1, 140,348,492,-1, 141,349,493,-1, 142,350,494,-1, 143,351,495,-1,
    144,256,624,672, 145,257,625,673, 146,258,626,674, 147,259,627,675, 148,260,628,676, 149,261,629,677, 150,262,630,678, 151,263,631,679,
    152,264,632,680, 153,265,633,681, 154,266,634,682, 155,267,635,683, 156,268,636,684, 157,269,637,685, 158,270,638,686, 159,271,639,687,
    160,272,640,688, 161,273,641,689, 162,274,642,690, 163,275,643,691, 164,276,644,692, 165,277,645,693, 166,278,646,694, 167,279,647,695,
    168,280,648,696, 169,281,649,697, 170,282,650,698, 171,283,651,699, 172,284,652,700, 173,285,653,701, 174,286,654,702, 175,287,655,703,
    176,288,496,-1, 177,289,497,-1, 178,290,498,-1, 179,291,499,-1, 180,292,500,-1, 181,293,501,-1, 182,294,502,-1, 183,295,503,-1,
    184,296,504,-1, 185,297,505,-1, 186,298,506,-1, 187,299,507,-1, 188,300,508,-1, 189,301,509,-1, 190,302,510,-1, 191,303,511,-1,
    192,224,656,704, 193,225,657,705, 194,226,658,706, 195,227,659,707, 196,228,660,708, 197,229,661,709, 198,230,662,710, 199,231,663,711,
    200,232,664,712, 201,233,665,713, 202,234,666,714, 203,235,667,715, 204,236,668,716, 205,237,669,717, 206,238,670,718, 207,239,671,719,
    208,240,512,-1, 209,241,513,-1, 210,242,514,-1, 211,243,515,-1, 212,244,516,-1, 213,245,517,-1, 214,246,518,-1, 215,247,519,-1,
    216,248,520,-1, 217,249,521,-1, 218,250,522,-1, 219,251,523,-1, 220,252,524,-1, 221,253,525,-1, 222,254,526,-1, 223,255,527,-1,
};
__global__ void __launch_bounds__(NWAVES * 64, 2) fwd(Args args) {
    extern __shared__ __attribute__((aligned(16))) unsigned char lds[];
    Frame F;
    F.lds = (LAS unsigned char*)lds; F.ldsg = (char*)lds;
    F.MISC = (volatile LAS unsigned*)(F.lds + MISC_OFF);
    F.wave = __builtin_amdgcn_readfirstlane((int)threadIdx.x >> 6); RETID();
    F.G = gridDim.x; { const int bx = blockIdx.x; F.vcu = (F.G % 8 == 0) ? (bx % 8) * (F.G / 8) + bx / 8 : bx; }
    unsigned char* ws = args.ws;
    F.ctl = (unsigned*)(ws + WS_CTL);
    for (int u = F.tid; u < (LDS_BYTES - LDSCTL_OFF) / 4; u += NWAVES * 64) ((LAS unsigned*)(F.lds + LDSCTL_OFF))[u] = 0u;
    __syncthreads();
    XcdBarrier bar; bar.bar = F.ctl + CW_BAR; bar.x = 0; bar.st = nullptr;
    const int lo = args.ph_lo, hi = args.ph_hi;
    const bool one = (hi - lo) > 1;
    if (one) bar = xcd_barrier_post(F.ctl + CW_BAR, F.MISC + 8, F.tid == 0);
#ifndef P0PROBE
#define P0PROBE 0
#endif
#ifndef REPMASK
#define REPMASK 0u
#endif
#ifndef PH_MASK
#define PH_MASK 0xFFFFFu
#endif
#define IN(k) ((((PH_MASK) >> (k)) & 1u) && lo <= (k) && (k) < hi)
#ifndef SEAMREP
#define SEAMREP 1
#endif
#define SEAM(k) do { if (IN(k) && IN((k) + 1)) { RETID(); for (int sr_ = 0; sr_ < SEAMREP; ++sr_) xcd_barrier(bar, F.tid == 0); } } while (0)
#define WIN ((bf16*)(ws + WS_WIN))
#define WBM ((bf16*)(ws + WS_WBM))
#define WBD ((bf16*)(ws + WS_WBD))
#define WMIX ((bf16*)(ws + WS_WMIX))
#define WXQ ((bf16*)(ws + WS_WXQ))
#define WXKV ((bf16*)(ws + WS_WXKV))
#define WXO ((bf16*)(ws + WS_WXO))
#define WGU ((bf16*)(ws + WS_WGU))
#define WDN ((bf16*)(ws + WS_WDN))
#define H ((bf16*)(ws + WS_H))
#define MEMN ((bf16*)(ws + WS_MEMN))
#define QKV ((bf16*)(ws + WS_QKV))
#define OM ((bf16*)(ws + WS_OM))
#define ODP ((bf16*)(ws + WS_ODP))
#define ODN ((bf16*)(ws + WS_ODN))
#define T1 ((bf16*)(ws + WS_T1))
#define MRG ((bf16*)(ws + WS_MRG))
#define X1 ((float*)(ws + WS_X1))
#define HX ((bf16*)(ws + WS_HX))
#define H8 ((unsigned char*)(ws + WS_H8))
#define HX8 ((unsigned char*)(ws + 1310 * MiB))
#define MEMN8 ((unsigned char*)(ws + 1332 * MiB))
#define W8 ((unsigned char*)(ws + WS_W8))
#define QX ((bf16*)(ws + WS_QX))
#define KVX ((bf16*)(ws + WS_KVX))
#define OX ((bf16*)(ws + WS_OX))
#define X2 ((bf16*)(ws + WS_X2))
#define HF ((bf16*)(ws + WS_HF))
#define ACT ((bf16*)(ws + WS_ACT))
#define YB ((bf16*)(ws + WS_Y))
#define LUT ((float*)(ws + WS_LUT))
#define TOK ((int*)(ws + WS_TOK))
#define CWT ((float*)(ws + WS_CW))
#define TSEL ((int*)(ws + WS_TSEL))
#define SEL ((unsigned short*)(ws + WS_SEL))
#define KMEAN ((float*)(ws + WS_KMEAN))
#define SSQ ((float*)(ws + WS_SS))
#define WRH ((bf16*)(ws + WS_WRH))
#define WRL ((bf16*)(ws + WS_WRL))
    const int gw = F.vcu * NWAVES + F.wave, NGW = F.G * NWAVES;

    for (int rep_ = IN(0) ? 1 + (int)(((REPMASK) >> 0) & 1u) : 0; rep_ > 0; --rep_) { RETID();
        LAS unsigned char* scr = F.lds + RING_OFF + F.wave * TR_LDS_PER_WAVE;
        tr_run<false>(gw, NGW, TI_IN, ws, scr, F.lane);
        tr_run<true>(TI_TOTAL + gw, NGW, TI_TOTAL + TI_W8, ws, scr, F.lane);
        for (int m = gw; m < T; m += NGW) rms_row_to_bf16(F.lane, AIN(0) + (size_t)m * DM, AIN(3), H + (size_t)m * DM, H8 + (size_t)m * LD8);
        for (int m = gw; m < NBATCH * MEMLEN; m += NGW) rms_row_to_bf16(F.lane, AIN(1) + (size_t)m * DM, AIN(14), MEMN + (size_t)m * DM, MEMN8 + (size_t)m * LD8);
        for (int i = F.vcu * (NWAVES * 64) + F.tid; i < NBATCH * 8 * 16 * 128; i += F.G * NWAVES * 64) KMEAN[i] = 0.f;
        for (int i = F.vcu * (NWAVES * 64) + F.tid; i < 2048 * 32; i += F.G * NWAVES * 64) { const int k = i >> 5, e = i & 31; const float w = AIN(20)[i]; const unsigned hi = f2bf(w); const float rem = w - __builtin_bit_cast(float, hi << 16);
            WRH[(size_t)e * 2048 + k] = (bf16)hi; WRL[(size_t)e * 2048 + k] = (bf16)f2bf(rem); }
        {
            const float* tb = AIN(2);
            for (int i = F.vcu * (NWAVES * 64) + F.tid; i < 12 * 128; i += F.G * NWAVES * 64) { const int h = i >> 7, d = i & 127; LUT[i] = (tb[rel_bucket(d) * 12 + h] - tb[31 * 12 + h]) * (1.0f / att::SCALE); }
        }
    }
    SEAM(0);
    for (int rep_ = IN(1) ? 1 + (int)(((REPMASK) >> 1) & 1u) : 0; rep_ > 0; --rep_) { RETID();
        const bool split = F.G >= 256; const int XG = split ? P1_GEMM_CUS : F.G;
        if ((int)blockIdx.x < XG) {
            { pg8::Gemm g{H, WIN, DM, 0, 0}; pg8::PanelOrder<0> S; S.init(T, XG, (int)blockIdx.x, split ? 4 : 8);
              pg8::EpiQKV E{QKV, LDQKV, KMEAN, 1.0f};
              pg8::gemm_phase<pg8::EpiQKV, pg8::PanelOrder<0>, true, false>(F.lds + RING_OFF, g, S, E, F.tid); }
            VM_WAIT(); __syncthreads();
            { pg8::Gemm g{(const bf16*)H8, (const bf16*)W8, DM, LD8, LD8}; pg8::PanelOrder<1> S; S.init(T, XG, XG - 1 - (int)blockIdx.x, split ? 4 : 8);
              pg8::EpiQKV E{QKV, LDQKV, KMEAN, 1.0f / 64.0f};
              pg8::gemm_phase<pg8::EpiQKV, pg8::PanelOrder<1>, true, false, true>(F.lds + RING_OFF, g, S, E, F.tid); }
        }
        if (!split || (int)blockIdx.x >= XG) {
            const int c0 = split ? (int)blockIdx.x - XG : (int)blockIdx.x, nc = split ? F.G - XG : F.G;
            tr_run<true>(TI_IN + c0 * NWAVES + F.wave, nc * NWAVES, split ? TI_S0 : TI_TOTAL, ws, F.lds + RING_OFF + F.wave * TR_LDS_PER_WAVE, F.lane);
        }
    }
    SEAM(1);
    for (int rep_ = IN(3) ? 1 + (int)(((REPMASK) >> 3) & 1u) : 0; rep_ > 0; --rep_) { RETID();
        LAS float* km = (LAS float*)(F.lds + RING_OFF);
        for (int it = F.vcu; it < NBATCH * 8 * 16; it += F.G) {
            const int b = it >> 7, h = (it >> 4) & 7, blk = it & 15;
            for (int i = F.tid; i < 16 * 128; i += NWAVES * 64) km[i] = KMEAN[(size_t)(b * 8 + h) * 2048 + i];
            __syncthreads();
            const int row = F.tid >> 1, half = F.tid & 1;
            const bf16* qp = QKV + ((size_t)b * SEQ + blk * 256 + row) * LDQKV + C_QA + h * 128 + half * 64;
            float q[64];
#pragma unroll
            for (int c = 0; c < 8; ++c) { const v4u w = *(const v4u*)(qp + 8 * c); q[8 * c] = bflo(w.x); q[8 * c + 1] = bfhi(w.x); q[8 * c + 2] = bflo(w.y); q[8 * c + 3] = bfhi(w.y);
                q[8 * c + 4] = bflo(w.z); q[8 * c + 5] = bfhi(w.z); q[8 * c + 6] = bflo(w.w); q[8 * c + 7] = bfhi(w.w); }
            float gate[16];
#pragma unroll
            for (int n = 0; n < 16; ++n) { float s = 0.f;
                if (n < blk) {
#pragma unroll
                    for (int d = 0; d < 64; d += 4) { const f32x4 kv = *(const LAS f32x4*)(km + n * 128 + half * 64 + d); s += q[d] * kv.x + q[d + 1] * kv.y + q[d + 2] * kv.z + q[d + 3] * kv.w; } }
                s += __shfl_xor(s, 1); gate[n] = s; }
            unsigned sel = 0u;
#pragma unroll
            for (int k = 0; k < 3; ++k) { float best = -__builtin_inff(); int bi = -1;
#pragma unroll
                for (int n = 0; n < 16; ++n) { const bool ok = (n < blk) && !((sel >> n) & 1u) && (bi < 0 || gate[n] > best); if (ok) { best = gate[n]; bi = n; } }
                if (bi >= 0) sel |= 1u << bi; }
            if (half == 0) SEL[(size_t)(b * 8 + h) * SEQ + blk * 256 + row] = (unsigned short)sel;
            __syncthreads();
        }
    }
    SEAM(3);
    for (int rep_ = IN(4) ? 1 + (int)(((REPMASK) >> 4) & 1u) : 0; rep_ > 0; --rep_) { RETID();
        constexpr int NIT = 768;
        const bool split4 = F.G >= 256; const int AG = split4 ? P4_ATT_CUS : F.G;
        const int bx4 = (int)blockIdx.x, av = split4 ? (bx4 % 8) * (AG / 8) + bx4 / 8 : F.vcu;
#define ITEM4(rnd_) (split4 ? ((rnd_) < 4 && ATT_LPT[av * 4 + ((rnd_) & 3)] >= 0 ? (int)ATT_LPT[av * 4 + ((rnd_) & 3)] : NIT) : (((rnd_) & 1) ? (rnd_) * AG + (AG - 1 - av) : (rnd_) * AG + av))
        int rnd = 0; int idx = ITEM4(0);
        if (split4 && bx4 >= AG) {
            tr_run<true>(TI_S0 + (bx4 - AG) * NWAVES + F.wave, (F.G - AG) * NWAVES, TI_TOTAL - TI_DEFER - TI_P10, ws, F.lds + RING_OFF + F.wave * TR_LDS_PER_WAVE, F.lane);
        } else if (idx < NIT) {
            att::BlockRef cur = mk_self_ref(idx, QKV, OM, ODP, LUT, SEL); att::Seam S;
            att::attn_prime(cur, F.ldsg + RING_OFF, S, F.tid);
            for (;;) {
                const int nidx = ITEM4(rnd + 1); const bool last = nidx >= NIT;
                att::BlockRef nxt = cur;
                att::attn_block<true>(cur, last ? -1 : nidx, [&](int i_) { nxt = mk_self_ref(i_, QKV, OM, ODP, LUT, SEL); return nxt; }, F.ldsg + RING_OFF, S, F.tid);
                if (last) break;
                cur = nxt; ++rnd;
            }
        }
        VM_WAIT(); __syncthreads();
    }
    SEAM(4);
    for (int rep_ = IN(5) ? 1 + (int)(((REPMASK) >> 5) & 1u) : 0; rep_ > 0; --rep_) { RETID();
        float lam;
        { const float a = AIN(5)[F.lane] * AIN(6)[F.lane] + AIN(5)[F.lane + 64] * AIN(6)[F.lane + 64];
          const float c = AIN(7)[F.lane] * AIN(8)[F.lane] + AIN(7)[F.lane + 64] * AIN(8)[F.lane + 64];
          lam = expf(wave_sum(a)) - expf(wave_sum(c)) + 0.2f; }
        const int hl = F.lane >> 5, j = F.lane & 31;
        const f32x4 g0 = *(const f32x4*)(AIN(9) + 8 * j), g1 = *(const f32x4*)(AIN(9) + 8 * j + 4);
        for (int it = gw; it < T * 2; it += NGW) {
            const int t = it >> 1, h = (it & 1) * 2 + hl;
            const bf16* p0 = ODP + (size_t)t * 2048 + (h * 2) * 256 + 8 * j; const bf16* p1 = p0 + 256;
            const v4u a = *(const v4u*)p0, c = *(const v4u*)p1;
            float o[8];
            o[0] = bflo(a.x) - lam * bflo(c.x); o[1] = bfhi(a.x) - lam * bfhi(c.x); o[2] = bflo(a.y) - lam * bflo(c.y); o[3] = bfhi(a.y) - lam * bfhi(c.y);
            o[4] = bflo(a.z) - lam * bflo(c.z); o[5] = bfhi(a.z) - lam * bfhi(c.z); o[6] = bflo(a.w) - lam * bflo(c.w); o[7] = bfhi(a.w) - lam * bfhi(c.w);
            float s2 = 0.f;
#pragma unroll
            for (int k = 0; k < 8; ++k) s2 += o[k] * o[k];
#pragma unroll
            for (int m = 1; m < 32; m <<= 1) s2 += __shfl_xor(s2, m);
            const float rs = 0.8f / sqrtf(s2 * (1.0f / 256.0f) + NORM_EPS);
            v4u w; w.x = pk2(o[0] * rs * g0.x, o[1] * rs * g0.y); w.y = pk2(o[2] * rs * g0.z, o[3] * rs * g0.w); w.z = pk2(o[4] * rs * g1.x, o[5] * rs * g1.y); w.w = pk2(o[6] * rs * g1.z, o[7] * rs * g1.w);
            *(v4u*)(ODN + (size_t)t * 1024 + h * 256 + 8 * j) = w;
        }
    }
    SEAM(5);
    for (int rep_ = IN(6) ? 1 + (int)(((REPMASK) >> 6) & 1u) : 0; rep_ > 0; --rep_) { RETID();
        { pg8::Gemm g{OM, WBM, 1024, OMP, OMP}; pg8::StaticOrder S; S.init(T, DM, F.G, (int)blockIdx.x);
          pg8::EpiGate<false> E{QKV + C_GA, LDQKV, nullptr, T1, DM, 1.0f / 1024.0f};
          pg8::gemm_phase<pg8::EpiGate<false>, pg8::StaticOrder, true, false, true>(F.lds + RING_OFF, g, S, E, F.tid); }
        VM_WAIT(); __syncthreads();
        { pg8::Gemm g{ODN, WBD, 1024, 0, 0}; pg8::StaticOrder S; S.init(T, DM, F.G, (int)blockIdx.x);
          pg8::EpiGate<true> E{QKV + C_GB, LDQKV, T1, MRG, DM, 1.0f};
          pg8::gemm_phase<pg8::EpiGate<true>, pg8::StaticOrder, true, false>(F.lds + RING_OFF, g, S, E, F.tid); }
    }
    SEAM(6);
    for (int rep_ = IN(7) ? 1 + (int)(((REPMASK) >> 7) & 1u) : 0; rep_ > 0; --rep_) { RETID();
        pg8::Gemm g{MRG, WMIX, DM, 0, 0}; pg8::StaticOrder S; S.init(T, DM, F.G, (int)blockIdx.x);
        pg8::EpiResF32X E{AIN(0), nullptr, DM, HX, SSQ, HX8, AIN(13), LD8};
        pg8::gemm_phase<pg8::EpiResF32X, pg8::StaticOrder, true, false>(F.lds + RING_OFF, g, S, E, F.tid);
    }
    SEAM(7);
    for (int rep_ = IN(9) ? 1 + (int)(((REPMASK) >> 9) & 1u) : 0; rep_ > 0; --rep_) { RETID();
        { pg8::Gemm g{(const bf16*)HX8, (const bf16*)WXQ, DM, LD8, LD8}; pg8::StaticOrder S; S.init(T, 512, F.G, (int)blockIdx.x);
          pg8::EpiXQ E{QX, 512, SSQ, NORM_EPS, 1.0f / 64.0f};
          pg8::gemm_phase<pg8::EpiXQ, pg8::StaticOrder, true, false, true>(F.lds + RING_OFF, g, S, E, F.tid); }
        VM_WAIT(); __syncthreads();
        { const int c2 = (int)blockIdx.x - 64; pg8::Gemm g{(const bf16*)MEMN8, (const bf16*)WXKV, DM, LD8, LD8}; pg8::StaticOrder S; S.init(NBATCH * MEMLEN, 1024, F.G, (c2 >= 0 && c2 < 8) ? c2 : -1);
          pg8::EpiBf16 E{KVX, 1024, 1.0f / 64.0f};
          pg8::gemm_phase<pg8::EpiBf16, pg8::StaticOrder, true, false, true>(F.lds + RING_OFF, g, S, E, F.tid); }
        if (F.G >= 256 && (int)blockIdx.x >= 72) {
            tr_run<true>(TI_TOTAL - TI_DEFER + ((int)blockIdx.x - 72) * NWAVES + F.wave, (F.G - 72) * NWAVES, TI_TOTAL, ws, F.lds + RING_OFF + F.wave * TR_LDS_PER_WAVE, F.lane);
        }
    }
    SEAM(9);
    for (int rep_ = IN(10) ? 1 + (int)(((REPMASK) >> 10) & 1u) : 0; rep_ > 0; --rep_) { RETID();
        int idx = F.vcu;
        if (idx < 128) {
            att::BlockRef cur = mk_cross_ref(idx, QX, KVX, OX); att::Seam S;
            att::attn_prime(cur, F.ldsg + RING_OFF, S, F.tid);
            for (;;) {
                const int nidx = idx + F.G; const bool last = nidx >= 128;
                att::BlockRef nxt = cur;
                att::attn_block<false, true>(cur, last ? -1 : nidx, [&](int i_) { nxt = mk_cross_ref(i_, QX, KVX, OX); return nxt; }, F.ldsg + RING_OFF, S, F.tid);
                if (last) break;
                cur = nxt; idx = nidx;
            }
        } else if (F.G >= 256) {
            tr_run<true>(TI_TOTAL - TI_DEFER - TI_P10 + (idx - 128) * NWAVES + F.wave, (F.G - 128) * NWAVES, TI_TOTAL - TI_DEFER, ws, F.lds + RING_OFF + F.wave * TR_LDS_PER_WAVE, F.lane);
        }
        VM_WAIT(); __syncthreads();
    }
    SEAM(10);
    for (int rep_ = IN(11) ? 1 + (int)(((REPMASK) >> 11) & 1u) : 0; rep_ > 0; --rep_) { RETID();
        pg8::Gemm g{OX, WXO, 512, OXP, OXP}; pg8::StaticOrder S; S.init(T, DM, F.G, (int)blockIdx.x);
        pg8::EpiResBfBf E{HX, X2, DM, 1.0f / 4096.0f};
        pg8::gemm_phase<pg8::EpiResBfBf, pg8::StaticOrder, true, false, true>(F.lds + RING_OFF, g, S, E, F.tid);
    }
    SEAM(11);
    for (int rep_ = IN(12) ? 1 + (int)(((REPMASK) >> 12) & 1u) : 0; rep_ > 0; --rep_) { RETID();
        constexpr int HP = 4112;
        LAS unsigned char* hsH = F.lds + RING_OFF;
        LAS unsigned char* hsL = F.lds + RING_OFF + 16 * HP;
        LAS float* part = (LAS float*)(F.lds + RING_OFF);
        LAS float* lg = (LAS float*)(F.lds + RING_OFF + 2 * 16 * HP);
        const float* br = AIN(21);
        typedef short bf16x8_t __attribute__((ext_vector_type(8)));
        LAS int* pkE = (LAS int*)(F.lds + TAB_OFF);
        LAS int* pkM = (LAS int*)(F.lds + TAB_OFF) + 128;
        LAS float* pkW = (LAS float*)(F.lds + RING_OFF + 2 * 16 * HP + 2048);
        LAS int* pkB = (LAS int*)(F.lds + RING_OFF + 2 * 16 * HP + 2048 + 512);
        int npick = 0;
        for (int base = F.vcu * 16; base < T; base += F.G * 16) {
            for (int rr = F.wave; rr < 16; rr += NWAVES) {
                const int m = base + rr;
                const GAS v2u* xr = (const GAS v2u*)(X2 + (size_t)m * DM) + F.lane; const GAS f32x4* gr = (const GAS f32x4*)AIN(19) + F.lane;
                f32x4 v[8]; float s2 = 0.f;
#pragma unroll
                for (int j = 0; j < 8; ++j) { const v2u w = xr[64 * j]; v[j].x = bflo(w.x); v[j].y = bfhi(w.x); v[j].z = bflo(w.y); v[j].w = bfhi(w.y);
                    s2 += (v[j].x * v[j].x + v[j].y * v[j].y) + (v[j].z * v[j].z + v[j].w * v[j].w); }
                const float rstd = 1.f / sqrtf(wave_sum(s2) * (1.f / DM) + NORM_EPS);
                GAS unsigned* o4 = (GAS unsigned*)((unsigned char*)HF + (size_t)m * LD8) + F.lane;
#pragma unroll
                for (int j = 0; j < 8; ++j) { const f32x4 gv = gr[64 * j]; float hn[4] = {v[j].x * rstd * gv.x, v[j].y * rstd * gv.y, v[j].z * rstd * gv.z, v[j].w * rstd * gv.w};
                    unsigned hi[4], lo[4];
#pragma unroll
                    for (int c = 0; c < 4; ++c) { hi[c] = f2bf(hn[c]); lo[c] = f2bf(hn[c] - __builtin_bit_cast(float, hi[c] << 16)); }
                    const v2u wh = {hi[0] | (hi[1] << 16), hi[2] | (hi[3] << 16)}, wl = {lo[0] | (lo[1] << 16), lo[2] | (lo[3] << 16)};
                    o4[64 * j] = pg8::pk4_fp8(hn[0], hn[1], hn[2], hn[3]);
                    *(LAS v2u*)(hsH + rr * HP + 8 * (F.lane + 64 * j)) = wh; *(LAS v2u*)(hsL + rr * HP + 8 * (F.lane + 64 * j)) = wl; }
            }
            __syncthreads();
            {
                const int fr = F.lane & 15, fq = F.lane >> 4;
                pg8::f32x4 acc0 = {0.f, 0.f, 0.f, 0.f}, acc1 = {0.f, 0.f, 0.f, 0.f};
#pragma unroll 2
                for (int ks = 0; ks < 8; ++ks) { const int k0 = F.wave * 256 + ks * 32 + fq * 8;
                    const bf16x8_t ah = *(const LAS bf16x8_t*)(hsH + fr * HP + k0 * 2), al = *(const LAS bf16x8_t*)(hsL + fr * HP + k0 * 2);
                    const bf16x8_t bh0 = *(const bf16x8_t*)(WRH + (size_t)fr * 2048 + k0), bl0 = *(const bf16x8_t*)(WRL + (size_t)fr * 2048 + k0);
                    const bf16x8_t bh1 = *(const bf16x8_t*)(WRH + (size_t)(16 + fr) * 2048 + k0), bl1 = *(const bf16x8_t*)(WRL + (size_t)(16 + fr) * 2048 + k0);
                    acc0 = __builtin_amdgcn_mfma_f32_16x16x32_bf16(ah, bh0, acc0, 0, 0, 0); acc0 = __builtin_amdgcn_mfma_f32_16x16x32_bf16(ah, bl0, acc0, 0, 0, 0); acc0 = __builtin_amdgcn_mfma_f32_16x16x32_bf16(al, bh0, acc0, 0, 0, 0);
                    acc1 = __builtin_amdgcn_mfma_f32_16x16x32_bf16(ah, bh1, acc1, 0, 0, 0); acc1 = __builtin_amdgcn_mfma_f32_16x16x32_bf16(ah, bl1, acc1, 0, 0, 0); acc1 = __builtin_amdgcn_mfma_f32_16x16x32_bf16(al, bh1, acc1, 0, 0, 0); }
                __syncthreads();
#pragma unroll
                for (int r = 0; r < 4; ++r) { part[(F.wave * 16 + 4 * fq + r) * 32 + fr] = acc0[r]; part[(F.wave * 16 + 4 * fq + r) * 32 + 16 + fr] = acc1[r]; }
            }
            __syncthreads();
            { const int r = F.tid >> 5, e = F.tid & 31; float s = br[e];
#pragma unroll
              for (int w = 0; w < 8; ++w) s += part[(w * 16 + r) * 32 + e];
              lg[r * 32 + e] = s; }
            __syncthreads();
            if (F.tid < 16) { const int m = base + F.tid; float l[32];
#pragma unroll
                for (int e = 0; e < 32; ++e) l[e] = lg[F.tid * 32 + e];
                int se[4]; float sv[4]; unsigned used = 0u;
#pragma unroll
                for (int k = 0; k < 4; ++k) { float best = -__builtin_inff(); int bi = 0;
#pragma unroll
                    for (int e = 0; e < 32; ++e) { const bool ok = !((used >> e) & 1u) && l[e] > best; if (ok) { best = l[e]; bi = e; } }
                    used |= 1u << bi; se[k] = bi; sv[k] = best; }
                float den = 0.f, ex[4];
#pragma unroll
                for (int k = 0; k < 4; ++k) { ex[k] = expf(sv[k] - sv[0]); den += ex[k]; }
#pragma unroll
                for (int k = 0; k < 4; ++k) { const int j = npick + F.tid * 4 + k; pkE[j] = se[k]; pkM[j] = m; pkW[j] = ex[k] / den; }
            }
            npick += 64;
            __syncthreads();
            if (npick == 128 || base + F.G * 16 >= T) {
                if (F.tid < 32) { int n = 0; for (int j = 0; j < npick; ++j) n += (pkE[j] == F.tid) ? 1 : 0;
                    pkB[F.tid] = n ? (int)__hip_atomic_fetch_add(F.ctl + CW_CNT + 64 * F.tid, (unsigned)n, RLX_AGENT) : 0; }
                __syncthreads();
                if (F.tid < npick) { const int j = F.tid, e = pkE[j]; int rank = 0; for (int i = 0; i < j; ++i) rank += (pkE[i] == e) ? 1 : 0;
                    const int pos = pkB[e] + rank, m = pkM[j];
                    TOK[(size_t)e * CAP + pos] = m; CWT[(size_t)e * CAP + pos] = pkW[j]; TSEL[(size_t)m * 4 + (j & 3)] = (e << 16) | pos; }
                npick = 0;
                __syncthreads();
            }
        }
    }
    SEAM(12);
    for (int rep_ = IN(13) ? 1 + (int)(((REPMASK) >> 13) & 1u) : 0; rep_ > 0; --rep_) { RETID();
        moe_tables(F);
        pg8::Gemm g{HF, WGU, DM, LD8, LD8}; pg8::MoeOrder S; S.init((const LAS int*)(F.lds + TAB_OFF), TOK, 16, F.G, (int)blockIdx.x, CAP);
        pg8::EpiGU E{AIN(23), (unsigned char*)ACT, LD8};
        pg8::gemm_phase<pg8::EpiGU, pg8::MoeOrder, true, true, true>(F.lds + RING_OFF, g, S, E, F.tid);
        VM_WAIT(); __syncthreads();
        { pg8::MoeTail S2; S2.init((const LAS int*)(F.lds + TAB_OFF), TOK, 16, F.G, (int)blockIdx.x, CAP);
          pg8::gemm_phase<pg8::EpiGU, pg8::MoeTail, true, true, true>(F.lds + RING_OFF, g, S2, E, F.tid); }
    }
    SEAM(13);
    for (int rep_ = IN(14) ? 1 + (int)(((REPMASK) >> 14) & 1u) : 0; rep_ > 0; --rep_) { RETID();
        moe_tables(F);
        pg8::Gemm g{ACT, WDN, DM, LD8, LD8}; pg8::MoeOrder S; S.init((const LAS int*)(F.lds + TAB_OFF), TOK, 8, F.G, (int)blockIdx.x, CAP);
        pg8::EpiDown E{AIN(25), CWT, CAP, YB};
        pg8::gemm_phase<pg8::EpiDown, pg8::MoeOrder, true, false, true>(F.lds + RING_OFF, g, S, E, F.tid);
        VM_WAIT(); __syncthreads();
        { pg8::MoeTail S2; S2.init((const LAS int*)(F.lds + TAB_OFF), TOK, 8, F.G, (int)blockIdx.x, CAP);
          pg8::gemm_phase<pg8::EpiDown, pg8::MoeTail, true, false, true>(F.lds + RING_OFF, g, S2, E, F.tid); }
    }
    SEAM(14);
    for (int rep_ = IN(15) ? 1 + (int)(((REPMASK) >> 15) & 1u) : 0; rep_ > 0; --rep_) { RETID();
        moe_tables(F);
        const LAS int* tab = (const LAS int*)(F.lds + TAB_OFF);
        const unsigned poison = xb_ld(F.ctl + CW_BAR + XB_TMO);
        for (int m = gw; m < T; m += NGW) {
            float v[4][8];
#pragma unroll
            for (int j = 0; j < 4; ++j) { const v4u w = *(const v4u*)(X2 + (size_t)m * DM + 8 * (F.lane + 64 * j));
                v[j][0] = bflo(w.x); v[j][1] = bfhi(w.x); v[j][2] = bflo(w.y); v[j][3] = bfhi(w.y); v[j][4] = bflo(w.z); v[j][5] = bfhi(w.z); v[j][6] = bflo(w.w); v[j][7] = bfhi(w.w); }
#pragma unroll
            for (int k = 0; k < 4; ++k) { const int ts = TSEL[(size_t)m * 4 + k]; const int e = ts >> 16, pos = ts & 0xffff; const size_t row = (size_t)tab[e] * 256 + pos;
#pragma unroll
                for (int j = 0; j < 4; ++j) { const v4u w = *(const v4u*)(YB + row * DM + 8 * (F.lane + 64 * j));
                    v[j][0] += bflo(w.x); v[j][1] += bfhi(w.x); v[j][2] += bflo(w.y); v[j][3] += bfhi(w.y); v[j][4] += bflo(w.z); v[j][5] += bfhi(w.z); v[j][6] += bflo(w.w); v[j][7] += bfhi(w.w); } }
            float s2 = 0.f;
#pragma unroll
            for (int j = 0; j < 4; ++j)
#pragma unroll
                for (int k = 0; k < 8; ++k) s2 += v[j][k] * v[j][k];
            float rstd = 1.f / sqrtf(wave_sum(s2) * (1.f / DM) + NORM_EPS);
            if (poison) rstd = __builtin_nanf("");
#pragma unroll
            for (int j = 0; j < 4; ++j) { const float* gp = AIN(26) + 8 * (F.lane + 64 * j); const f32x4 ga = *(const f32x4*)gp, gb = *(const f32x4*)(gp + 4);
                f32x4 oa, ob; oa.x = v[j][0] * rstd * ga.x; oa.y = v[j][1] * rstd * ga.y; oa.z = v[j][2] * rstd * ga.z; oa.w = v[j][3] * rstd * ga.w;
                ob.x = v[j][4] * rstd * gb.x; ob.y = v[j][5] * rstd * gb.y; ob.z = v[j][6] * rstd * gb.z; ob.w = v[j][7] * rstd * gb.w;
                *(f32x4*)((kargs()->out) + (size_t)m * DM + 8 * (F.lane + 64 * j)) = oa; *(f32x4*)((kargs()->out) + (size_t)m * DM + 8 * (F.lane + 64 * j) + 4) = ob; }
        }
    }
#undef IN
#undef SEAM
}

extern "C" void kernel_launch(void* const* d_in, const int* in_sizes, int n_in, void* d_out, int out_size, void* d_ws, size_t ws_size, hipStream_t stream) {
    static int grid = 0;
    if (grid == 0) {
        if (n_in != 27 || out_size != T * DM || ws_size < WS_END) { fprintf(stderr, "kernel_launch: unexpected shapes (n_in %d out %d ws %zu)\n", n_in, out_size, ws_size); grid = -1; return; }
        int dev = 0, cus = 0, per_cu = 0;
        if (hipGetDevice(&dev) != hipSuccess || hipDeviceGetAttribute(&cus, hipDeviceAttributeMultiprocessorCount, dev) != hipSuccess) { grid = -1; return; }
        if (hipFuncSetAttribute((const void*)fwd, hipFuncAttributeMaxDynamicSharedMemorySize, LDS_BYTES) != hipSuccess) { fprintf(stderr, "kernel_launch: hipFuncSetAttribute failed\n"); grid = -1; return; }
        if (hipOccupancyMaxActiveBlocksPerMultiprocessor(&per_cu, (const void*)fwd, NWAVES * 64, LDS_BYTES) != hipSuccess || per_cu < 1) fprintf(stderr, "kernel_launch: occupancy query reports %d\n", per_cu);
        (void)hipGetLastError();
        grid = cus;
    }
    if (grid < 0) return;
    if (hipMemsetAsync((char*)d_ws + WS_CTL, 0, CTL_ZERO_BYTES, stream) != hipSuccess) return;
    Args a{};
    for (int i = 0; i < 27; ++i) a.in[i] = (const float*)d_in[i];
    a.out = (float*)d_out; a.ws = (unsigned char*)d_ws;
#if MK_ONE_LAUNCH
    a.ph_lo = 0; a.ph_hi = N_PHASES + 1;
    hipLaunchKernelGGL(fwd, dim3(grid), dim3(NWAVES * 64), LDS_BYTES, stream, a);
#else
    for (int p = 0; p <= N_PHASES; ++p) { a.ph_lo = p; a.ph_hi = p + 1; hipLaunchKernelGGL(fwd, dim3(grid), dim3(NWAVES * 64), LDS_BYTES, stream, a); }
#endif
}
```
